# Optimizing an MI355X kernel written in HIP

```python
import jax
import jax.numpy as jnp
from jax import lax
import numpy as np

D_MODEL = 1024
BATCH = 8
SEQ = 2048
DEPTH = 2

CTX_LEN = 256
GRID_W = 64
N_BRANCH = 4
BR_W = D_MODEL // 2
HEAD_DIM = 128
A_HEADS = BR_W // HEAD_DIM
A_KV_HEADS = A_HEADS // 2
A_GROUP = A_HEADS // A_KV_HEADS
Q_BLOCK = 128
ROPE_THETA = 10000.0
AXIS_DIM = HEAD_DIM // 2
B_CONV = 3
C_HEADS = 4
C_HEAD_K = BR_W // (2 * C_HEADS)
C_HEAD_V = BR_W // C_HEADS
C_KEY_W = C_HEADS * C_HEAD_K
C_GATE_RANK = 16
C_GATE_TAU = 16.0
C_CHUNK = 64
D_CONV = 31
ALPHA = (2 * DEPTH) ** 0.25
BETA = (8 * DEPTH) ** -0.25
EPS = 1e-6
IN_WIDTHS = (
    A_HEADS * HEAD_DIM, A_KV_HEADS * HEAD_DIM, A_KV_HEADS * HEAD_DIM, BR_W,
    BR_W, BR_W, BR_W, BR_W,
    C_KEY_W, C_KEY_W, C_HEADS * C_HEAD_V, BR_W, 2 * C_GATE_RANK,
    2 * BR_W, BR_W,
    N_BRANCH * D_MODEL,
)

kernel_name = 'hybrid_parallel_branch_diffusion_block'


def layer_norm(x):
    xf = x.astype(jnp.float32)
    mu = jnp.mean(xf, -1, keepdims=True)
    var = jnp.mean(jnp.square(xf - mu), -1, keepdims=True)
    return ((xf - mu) * lax.rsqrt(var + EPS)).astype(x.dtype)


def rms_norm(x, g):
    xf = x.astype(jnp.float32)
    y = xf * lax.rsqrt(jnp.mean(jnp.square(xf), -1, keepdims=True) + EPS)
    return y.astype(x.dtype) * g


def split_cols(w):
    cuts = [int(i) for i in np.cumsum(IN_WIDTHS)[:-1]]
    return jnp.split(w, cuts, axis=-1)


def dwconv(x, w):
    k, ch = w.shape
    return lax.conv_general_dilated(x, w[:, None, :].astype(x.dtype), (1,), [(k // 2, k // 2)],
                                    dimension_numbers=('NWC', 'WIO', 'NWC'), feature_group_count=ch)


def apply_rope(x, cos, sin):
    xp = x.reshape(x.shape[:-1] + (HEAD_DIM // 2, 2))
    x0, x1 = xp[..., 0], xp[..., 1]
    c = cos[:, None, :].astype(x.dtype)
    s = sin[:, None, :].astype(x.dtype)
    return jnp.stack([x0 * c - x1 * s, x0 * s + x1 * c], -1).reshape(x.shape)


def attn_heads(q, k, v, q_g, k_g, cos, sin):
    b, t, _ = q.shape
    qh = rms_norm(q.reshape(b, t, A_HEADS, HEAD_DIM), q_g)
    kh = rms_norm(k.reshape(b, t, A_KV_HEADS, HEAD_DIM), k_g)
    if cos is not None:
        qh = apply_rope(qh, cos, sin)
        kh = apply_rope(kh, cos, sin)
    qh = qh.reshape(b, t, A_KV_HEADS, A_GROUP, HEAD_DIM).transpose(0, 2, 3, 1, 4)
    kh = kh.transpose(0, 2, 1, 3)
    vh = v.reshape(b, t, A_KV_HEADS, HEAD_DIM).transpose(0, 2, 1, 3)
    return qh, kh, vh


def softmax_attention(q, k, v):
    s = jnp.einsum('bkgqd,bksd->bkgqs', q, k).astype(jnp.float32) * HEAD_DIM ** -0.5
    p = jax.nn.softmax(s, axis=-1).astype(v.dtype)
    return jnp.einsum('bkgqs,bksd->bkgqd', p, v)


def block_attention(q, k, v):
    b, kv, g, t, hd = q.shape
    nb = t // Q_BLOCK
    qb = q.reshape(b, kv, g, nb, Q_BLOCK, hd).transpose(3, 0, 1, 2, 4, 5)
    o = lax.map(lambda qi: softmax_attention(qi, k, v), qb)
    return o.transpose(1, 0, 4, 2, 3, 5).reshape(b, t, kv * g * hd)


def merge_heads(o):
    b, kv, g, t, hd = o.shape
    return o.transpose(0, 3, 1, 2, 4).reshape(b, t, kv * g * hd)


def gla_chunked(q, k, v, g, s0, want_out):
    b, h, l, _ = q.shape
    dv = v.shape[-1]
    n = l // C_CHUNK

    def chunks(a):
        return a.astype(jnp.float32).reshape(b, h, n, C_CHUNK, a.shape[-1]).transpose(2, 0, 1, 3, 4)

    mask = jnp.tril(jnp.ones((C_CHUNK, C_CHUNK), dtype=bool))[:, :, None]

    def step(s, inp):
        qc, kc, vc, gc = inp
        cum = jnp.cumsum(gc, axis=2)
        last = cum[:, :, -1:, :]
        s_new = jnp.exp(last[:, :, 0, :])[..., None] * s + jnp.einsum('bhjd,bhjv->bhdv', kc * jnp.exp(last - cum), vc)
        if not want_out:
            return s_new, None
        diff = cum[:, :, :, None, :] - cum[:, :, None, :, :]
        decay = jnp.exp(jnp.where(mask, diff, -jnp.inf))
        scores = jnp.einsum('bhid,bhjd,bhijd->bhij', qc, kc, decay)
        o = jnp.einsum('bhij,bhjv->bhiv', scores, vc) + jnp.einsum('bhid,bhdv->bhiv', qc * jnp.exp(cum), s)
        return s_new, o

    s_fin, o = lax.scan(step, s0, (chunks(q), chunks(k), chunks(v), chunks(g)))
    if not want_out:
        return None, s_fin
    return o.transpose(1, 2, 0, 3, 4).reshape(b, h, l, dv).astype(v.dtype), s_fin


def gla_branch(side_c, side_l, w2, b2, norm_g, want_ctx):
    def heads(a, d):
        return a.reshape(a.shape[0], a.shape[1], C_HEADS, d).transpose(0, 2, 1, 3)

    def prep(q, k, v, r):
        gates = [heads(jax.nn.log_sigmoid((r[..., i * C_GATE_RANK:(i + 1) * C_GATE_RANK] @ w2[i] + b2[i])
                                          .astype(jnp.float32)) / C_GATE_TAU, C_HEAD_K) for i in range(2)]
        return heads(q, C_HEAD_K) * C_HEAD_K ** -0.5, heads(k, C_HEAD_K), heads(v, C_HEAD_V), gates[0], gates[1]

    def flip(a):
        return jnp.flip(a, axis=2)

    qc, kc, vc, gcf, gcb = prep(*side_c)
    ql, kl, vl, glf, glb = prep(*side_l)
    s0 = jnp.zeros((qc.shape[0], C_HEADS, C_HEAD_K, C_HEAD_V), jnp.float32)
    oc_f, sc_f = gla_chunked(qc, kc, vc, gcf, s0, want_ctx)
    oc_b, sc_b = gla_chunked(flip(qc), flip(kc), flip(vc), flip(gcb), s0, want_ctx)
    ol_f, _ = gla_chunked(ql, kl, vl, glf, sc_f, True)
    ol_b, _ = gla_chunked(flip(ql), flip(kl), flip(vl), flip(glb), sc_b, True)

    def finish(of, ob):
        o = rms_norm(of + flip(ob), norm_g.reshape(C_HEADS, 1, C_HEAD_V))
        return o.transpose(0, 2, 1, 3).reshape(o.shape[0], o.shape[2], C_HEADS * C_HEAD_V)

    y_ctx = finish(oc_f, oc_b) if want_ctx else None
    return y_ctx, finish(ol_f, ol_b)


def short_conv(bg, cg, xin, z, w):
    return bg * dwconv(cg * xin, w) * jax.nn.silu(z)


def conformer_conv(glu, z, w, bias, g, beta):
    a, gt = jnp.split(glu, 2, axis=-1)
    hh = dwconv(a * jax.nn.sigmoid(gt), w) + bias
    hh = layer_norm(hh) * g + beta
    return jax.nn.silu(hh) * jax.nn.silu(z)


def merge(branches, mg, w_br, w_out):
    b, t, _ = mg.shape
    gates = jax.nn.sigmoid(mg.reshape(b, t, N_BRANCH, D_MODEL))
    acc = gates[:, :, 0] * (branches[0] @ w_br[0])
    for i in range(1, N_BRANCH):
        acc = acc + gates[:, :, i] * (branches[i] @ w_br[i])
    return acc @ w_out


def mixer(u_ctx, u_lat, cos, sin, w_in, q_g, k_g, b_w, c_w2, c_b2, c_g, d_w, d_b, d_g, d_beta, w_br, w_out, want_ctx):
    w_parts = split_cols(w_in)
    pc = [u_ctx @ w for w in w_parts]
    pl = [u_lat @ w for w in w_parts]
    qa_l, ka_l, va_l = attn_heads(pl[0], pl[1], pl[2], q_g, k_g, cos, sin)
    qa_c, ka_c, va_c = attn_heads(pc[0], pc[1], pc[2], q_g, k_g, None, None)
    ya_l = block_attention(qa_l, jnp.concatenate([ka_l, ka_c], 2), jnp.concatenate([va_l, va_c], 2)) * jax.nn.silu(pl[3])
    yc_c, yc_l = gla_branch((pc[8], pc[9], pc[10], pc[12]), (pl[8], pl[9], pl[10], pl[12]), c_w2, c_b2, c_g, want_ctx)
    yc_l = yc_l * jax.nn.silu(pl[11])

    def local_branches(p):
        yb = short_conv(p[4], p[5], p[6], p[7], b_w)
        yd = conformer_conv(p[13], p[14], d_w, d_b, d_g, d_beta)
        return yb, yd

    yb_l, yd_l = local_branches(pl)
    y_lat = merge([ya_l, yb_l, yc_l, yd_l], pl[15], w_br, w_out)
    if not want_ctx:
        return None, y_lat
    ya_c = merge_heads(softmax_attention(qa_c, ka_c, va_c)) * jax.nn.silu(pc[3])
    yb_c, yd_c = local_branches(pc)
    y_ctx = merge([ya_c, yb_c, yc_c * jax.nn.silu(pc[11]), yd_c], pc[15], w_br, w_out)
    return y_ctx, y_lat


def setup_inputs(seed: int = 0) -> dict:
    key = jax.random.key(seed)
    ks = jax.random.split(key, 24)

    def nrm(k, shape, s):
        return jax.random.normal(k, shape, jnp.float32) * s

    total_in = sum(IN_WIDTHS)
    return {
        'x': nrm(ks[0], (BATCH, SEQ, D_MODEL), 1.0),
        'c': nrm(ks[1], (BATCH, D_MODEL), 1.0),
        'ctx': nrm(ks[2], (BATCH, CTX_LEN, D_MODEL), 1.0),
        'c_ctx': nrm(ks[3], (D_MODEL,), 1.0),
        'w_mod': nrm(ks[4], (DEPTH, D_MODEL, 3 * D_MODEL), D_MODEL ** -0.5),
        'b_mod': nrm(ks[5], (DEPTH, 3 * D_MODEL), 0.02),
        'w_in': nrm(ks[6], (DEPTH, D_MODEL, total_in), D_MODEL ** -0.5),
        'q_norm': 1.0 + nrm(ks[7], (DEPTH, HEAD_DIM), 0.02),
        'k_norm': 1.0 + nrm(ks[8], (DEPTH, HEAD_DIM), 0.02),
        'b_conv': nrm(ks[9], (DEPTH, B_CONV, BR_W), B_CONV ** -0.5),
        'c_gate_w2': nrm(ks[10], (DEPTH, 2, C_GATE_RANK, C_KEY_W), C_GATE_RANK ** -0.5),
        'c_gate_b': nrm(ks[11], (DEPTH, 2, C_KEY_W), 0.1),
        'c_norm': 1.0 + nrm(ks[12], (DEPTH, BR_W), 0.02),
        'd_conv_w': nrm(ks[13], (DEPTH, D_CONV, BR_W), D_CONV ** -0.5),
        'd_conv_b': nrm(ks[14], (DEPTH, BR_W), 0.02),
        'd_norm_g': 1.0 + nrm(ks[15], (DEPTH, BR_W), 0.02),
        'd_norm_b': nrm(ks[16], (DEPTH, BR_W), 0.02),
        'w_br': nrm(ks[17], (DEPTH, N_BRANCH, BR_W, D_MODEL), BETA * BR_W ** -0.5),
        'w_out': nrm(ks[18], (DEPTH, D_MODEL, D_MODEL), BETA * D_MODEL ** -0.5),
        'ln_g': 1.0 + nrm(ks[19], (DEPTH, D_MODEL), 0.02),
        'ln_b': nrm(ks[20], (DEPTH, D_MODEL), 0.02),
    }


def reference(x, c, ctx, c_ctx, w_mod, b_mod, w_in, q_norm, k_norm, b_conv, c_gate_w2, c_gate_b, c_norm,
              d_conv_w, d_conv_b, d_norm_g, d_norm_b, w_br, w_out, ln_g, ln_b):
    rows = x.shape[1] // GRID_W
    row = jnp.repeat(jnp.arange(rows), GRID_W).astype(jnp.float32)
    col = jnp.tile(jnp.arange(GRID_W), rows).astype(jnp.float32)
    inv = ROPE_THETA ** (-jnp.arange(0, AXIS_DIM, 2, dtype=jnp.float32) / AXIS_DIM)
    ang = jnp.concatenate([row[:, None] * inv, col[:, None] * inv], -1)
    cos, sin = jnp.cos(ang), jnp.sin(ang)
    sc = jax.nn.silu(c)
    scc = jax.nn.silu(c_ctx)
    h_lat, h_ctx = x, ctx
    for l in range(DEPTH):
        want_ctx = l < DEPTH - 1
        shift, scale, gate = jnp.split(sc @ w_mod[l] + b_mod[l], 3, axis=-1)
        shift_c, scale_c, gate_c = jnp.split(scc @ w_mod[l] + b_mod[l], 3, axis=-1)
        u_lat = layer_norm(h_lat) * (1.0 + scale[:, None]) + shift[:, None]
        u_ctx = layer_norm(h_ctx) * (1.0 + scale_c) + shift_c
        y_ctx, y_lat = mixer(u_ctx, u_lat, cos, sin, w_in[l], q_norm[l], k_norm[l], b_conv[l], c_gate_w2[l],
                             c_gate_b[l], c_norm[l], d_conv_w[l], d_conv_b[l], d_norm_g[l], d_norm_b[l],
                             w_br[l], w_out[l], want_ctx)
        h_lat = layer_norm(ALPHA * h_lat + gate[:, None] * y_lat) * ln_g[l] + ln_b[l]
        if want_ctx:
            h_ctx = layer_norm(ALPHA * h_ctx + gate_c * y_ctx) * ln_g[l] + ln_b[l]
    return h_lat
```

```cpp
#include <hip/hip_runtime.h>
#include <hip/hip_bf16.h>
#include <hip/hip_cooperative_groups.h>
#include <cstdio>
#include <cstdint>
namespace cg = cooperative_groups;
#ifndef PH
#define PH 2047
#endif

constexpr int DM = 1024, NBATCH = 8, SEQ = 2048, CTX = 256, TPB = CTX + SEQ, NTOK = NBATCH * TPB;
constexpr int NCOL = 10752, WIN_COLS = 10784;
constexpr float EPS = 1e-6f, ALPHA = 1.41421356237f;
constexpr int C_BG = 0, C_CG = 512, C_XIN = 1024, C_GLU = 1536, C_AQ = 2560, C_AK = 3072, C_AV = 3328, C_CQ = 3584, C_CK = 3840, C_CV = 4096,
              C_ZA = 4608, C_ZB = 5120, C_ZC = 5632, C_ZD = 6144, C_MG = 6656;
constexpr size_t WS_WIN = 0;
constexpr size_t WS_WR = WS_WIN + (size_t)2 * NCOL * 1024 * 2;
constexpr size_t WS_WBR = WS_WR + (size_t)2 * 32 * 1024 * 2;
constexpr size_t WS_WOUT = WS_WBR + (size_t)2 * 4 * 1024 * 512 * 2;
constexpr size_t WS_MOD = WS_WOUT + (size_t)2 * 1024 * 1024 * 2;
constexpr size_t WS_U = WS_MOD + (size_t)2 * 9 * 3072 * 4;
constexpr size_t WS_R = WS_U + (size_t)NTOK * 1024 * 2;
constexpr size_t WS_HCTX = WS_R + (size_t)NTOK * 32 * 4;
constexpr size_t WS_P = WS_HCTX + (size_t)NBATCH * CTX * 1024 * 4;
constexpr int LDS_BYTES = 131072 + 1024;

typedef unsigned short bf16_t;
typedef short bf16x8 __attribute__((ext_vector_type(8)));
typedef float f32x4 __attribute__((ext_vector_type(4)));
typedef unsigned u32x4 __attribute__((ext_vector_type(4)));

struct Params {
    const float *x, *c, *ctx, *c_ctx, *w_mod, *b_mod, *w_in, *q_norm, *k_norm, *b_conv, *c_gate_w2, *c_gate_b, *c_norm,
                *d_conv_w, *d_conv_b, *d_norm_g, *d_norm_b, *w_br, *w_out, *ln_g, *ln_b;
    float* out; unsigned char* ws;
    int ng, tg;
};

__device__ __forceinline__ int otid() { int t = threadIdx.x; asm volatile("" : "+v"(t)); return t; }
__device__ __forceinline__ float bf2f(unsigned v) { return __uint_as_float(v << 16); }
__device__ __forceinline__ unsigned f2bf(float f) { unsigned u = __float_as_uint(f); return (u + 0x7fffu + ((u >> 16) & 1u)) >> 16; }
__device__ __forceinline__ unsigned pk2(float lo, float hi) { return f2bf(lo) | (f2bf(hi) << 16); }
__device__ __forceinline__ float sigm(float x) { return 1.f / (1.f + __expf(-x)); }
__device__ __forceinline__ float silu(float x) { return x / (1.f + __expf(-x)); }
__device__ __forceinline__ float wave_sum(float v) {
#pragma unroll
    for (int o = 32; o > 0; o >>= 1) v += __shfl_xor(v, o);
    return v;
}
__device__ __forceinline__ bf16_t* subbuf(const Params& p, int col) { return (bf16_t*)(p.ws + WS_P + (size_t)col * p.tg * 2); }
struct SubInfo { int col0, width, orig0; };
__device__ __forceinline__ SubInfo sub_info(int col) {
    if (col < 512) return {0, 512, 1536};
    if (col < 1024) return {512, 512, 2048};
    if (col < 1536) return {1024, 512, 2560};
    if (col < 2560) return {1536, 1024, 5152};
    if (col < 3072) return {2560, 512, 0};
    if (col < 3328) return {3072, 256, 512};
    if (col < 3584) return {3328, 256, 768};
    if (col < 3840) return {3584, 256, 3584};
    if (col < 4096) return {3840, 256, 3840};
    if (col < 4608) return {4096, 512, 4096};
    if (col < 5120) return {4608, 512, 1024};
    if (col < 5632) return {5120, 512, 3072};
    if (col < 6144) return {5632, 512, 4608};
    if (col < 6656) return {6144, 512, 6176};
    return {6656, 4096, 6688};
}
__device__ __forceinline__ const float* h_in_row(const Params& p, int l, int grow) {
    const int b = grow / TPB, s = grow % TPB;
    if (l == 0) return s < CTX ? p.ctx + ((size_t)b * CTX + s) * 1024 : p.x + ((size_t)b * SEQ + (s - CTX)) * 1024;
    return s < CTX ? (const float*)(p.ws + WS_HCTX) + ((size_t)b * CTX + s) * 1024 : p.out + ((size_t)b * SEQ + (s - CTX)) * 1024;
}
namespace att {
using bf16 = __hip_bfloat16;
constexpr int D = 128, NW = 8, QBLK = 32, KVBLK = 64;
constexpr float SCALE = 0.088388347648318440f;
constexpr float THR = 8.f;
constexpr int SDEPTH = 2;
constexpr int LDQ = 512, LDK = 256, LDZ = 512;
constexpr size_t SHM_V = KVBLK * D * 2, SHM_K = KVBLK * D * 2, SHM_ATTN = 2 * SHM_V + 2 * SHM_K + NW * 64 * 4;
using bf16x8 = __attribute__((ext_vector_type(8))) short;
using s16x4  = __attribute__((ext_vector_type(4))) short;
using f32x16 = __attribute__((ext_vector_type(16))) float;
using f32x8  = __attribute__((ext_vector_type(8))) float;
using u32x4  = __attribute__((ext_vector_type(4))) unsigned;
#define KSWZ(row, colB) ((row) * 256 + ((colB) ^ (((row) & 7) << 4)))
#define SBAR() __builtin_amdgcn_sched_barrier(0)
__device__ __forceinline__ int crow(int r, int hi) { return (r & 3) + 8 * (r >> 2) + 4 * hi; }
__device__ __forceinline__ unsigned cvtpk(float lo, float hi) {
  unsigned r; asm volatile("v_cvt_pk_bf16_f32 %0, %1, %2" : "=v"(r) : "v"(lo), "v"(hi)); return r;
}
template <typename TIn> struct Stage;
template <> struct Stage<bf16>  { using T = bf16x8;
  __device__ static __forceinline__ T ld8(const bf16* p) { return *reinterpret_cast<const bf16x8*>(p); }
  __device__ static __forceinline__ bf16x8 tobf(T x) { return x; } };
__device__ __forceinline__ void partialSM(f32x16& p0, f32x16& p1, float& m_reg, float& mn, float& alpha) {
  constexpr float C = SCALE * 1.4426950408889634f;
  float pmax = p0[0]; for (int r = 1; r < 16; ++r) pmax = fmaxf(pmax, p0[r]); for (int r = 0; r < 16; ++r) pmax = fmaxf(pmax, p1[r]);
  { auto rr = __builtin_amdgcn_permlane32_swap(__float_as_uint(pmax), __float_as_uint(pmax), false, false);
    pmax = fmaxf(__uint_as_float(rr[0]), __uint_as_float(rr[1])); }
  if (__builtin_expect(__all(pmax - m_reg <= THR / SCALE), 1)) { mn = m_reg; alpha = 1.f; }
  else { mn = fmaxf(m_reg, pmax); alpha = __builtin_amdgcn_exp2f((m_reg - mn) * C); m_reg = mn; }
  float mnC = -mn * C;
  for (int r = 0; r < 16; ++r) p0[r] = fmaf(p0[r], C, mnC); for (int r = 0; r < 16; ++r) p1[r] = fmaf(p1[r], C, mnC);
  for (int r = 0; r < 16; ++r) p0[r] = __builtin_amdgcn_exp2f(p0[r]);
}
__device__ __forceinline__ void finishSM(f32x16& p0, f32x16& p1, float alpha, float& l_reg, bf16x8& pa0, bf16x8& pa1, bf16x8& pa2, bf16x8& pa3) {
  for (int r = 0; r < 16; ++r) p1[r] = __builtin_amdgcn_exp2f(p1[r]);
  float ps = 0; for (int r = 0; r < 16; ++r) ps += p0[r]; for (int r = 0; r < 16; ++r) ps += p1[r];
  { auto rr = __builtin_amdgcn_permlane32_swap(__float_as_uint(ps), __float_as_uint(ps), false, false);
    ps = __uint_as_float(rr[0]) + __uint_as_float(rr[1]); }
  l_reg = l_reg * alpha + ps;
#define PK4(P, BASE, OUT) do { unsigned a0 = cvtpk(P[BASE + 0], P[BASE + 1]), a1 = cvtpk(P[BASE + 2], P[BASE + 3]);   \
    unsigned b0 = cvtpk(P[BASE + 4], P[BASE + 5]), b1 = cvtpk(P[BASE + 6], P[BASE + 7]);                              \
    auto r0 = __builtin_amdgcn_permlane32_swap(a0, b0, false, false); auto r1 = __builtin_amdgcn_permlane32_swap(a1, b1, false, false); \
    u32x4 w = {r0[0], r1[0], r0[1], r1[1]}; OUT = *reinterpret_cast<bf16x8*>(&w); } while (0)
  PK4(p0, 0, pa0); PK4(p0, 8, pa1); PK4(p1, 0, pa2); PK4(p1, 8, pa3);
#undef PK4
}
__device__ __forceinline__ void qkt(f32x16& p0, f32x16& p1, const bf16* Ks, const bf16x8* qr, int r32, int hi) {
  p0 = f32x16{}; p1 = f32x16{};
  for (int d0 = 0; d0 < 8; ++d0) { int cb = (d0 * 16 + hi * 8) * 2;
    bf16x8 b0 = *reinterpret_cast<const bf16x8*>((const char*)Ks + KSWZ(r32, cb));
    bf16x8 b1 = *reinterpret_cast<const bf16x8*>((const char*)Ks + KSWZ(32 + r32, cb));
    p0 = __builtin_amdgcn_mfma_f32_32x32x16_bf16(b0, qr[d0], p0, 0, 0, 0);
    p1 = __builtin_amdgcn_mfma_f32_32x32x16_bf16(b1, qr[d0], p1, 0, 0, 0); }
}
__device__ __forceinline__ int v_st(int k, int c) { const int kk = (k & ~0xC) | ((k & 4) << 1) | ((k & 8) >> 1); return ((kk >> 3) * 4 + (c >> 5)) * 512 + ((kk & 7) * 32 + (c & 31)) * 2; }
__device__ __forceinline__ int v_rd_base(int lane) { return ((lane & 3) << 3) | (((lane >> 2) & 3) << 6) | (((lane >> 4) & 1) << 5) | (((lane >> 5) & 1) << 8); }
constexpr int v_rd_off(int d0, int ks, int half) { return d0 * 512 + ks * 4096 + half * 2048; }
template <int OFF> __device__ __forceinline__ s16x4 tr_read(int vb) {
  s16x4 r; asm volatile("ds_read_b64_tr_b16 %0, %1 offset:%2" : "=&v"(r) : "v"(vb), "i"(OFF) : "memory"); return r;
}
template <int D0> __device__ __forceinline__ void pv_one(f32x16& od, int vb, bf16x8 pa0, bf16x8 pa1, bf16x8 pa2, bf16x8 pa3) {
  const s16x4 l0 = tr_read<v_rd_off(D0, 0, 0)>(vb), h0 = tr_read<v_rd_off(D0, 0, 1)>(vb), l1 = tr_read<v_rd_off(D0, 1, 0)>(vb), h1 = tr_read<v_rd_off(D0, 1, 1)>(vb);
  const s16x4 l2 = tr_read<v_rd_off(D0, 2, 0)>(vb), h2 = tr_read<v_rd_off(D0, 2, 1)>(vb), l3 = tr_read<v_rd_off(D0, 3, 0)>(vb), h3 = tr_read<v_rd_off(D0, 3, 1)>(vb);
  asm volatile("s_waitcnt lgkmcnt(0)" ::: "memory"); SBAR();
#define PK(L, H) (bf16x8){L[0], L[1], L[2], L[3], H[0], H[1], H[2], H[3]}
  od = __builtin_amdgcn_mfma_f32_32x32x16_bf16(pa0, PK(l0, h0), od, 0, 0, 0);
  od = __builtin_amdgcn_mfma_f32_32x32x16_bf16(pa1, PK(l1, h1), od, 0, 0, 0);
  od = __builtin_amdgcn_mfma_f32_32x32x16_bf16(pa2, PK(l2, h2), od, 0, 0, 0);
  od = __builtin_amdgcn_mfma_f32_32x32x16_bf16(pa3, PK(l3, h3), od, 0, 0, 0);
#undef PK
}
__device__ __forceinline__ void pv_d0(f32x16* o, int vb, bf16x8 pa0, bf16x8 pa1, bf16x8 pa2, bf16x8 pa3) {
  pv_one<0>(o[0], vb, pa0, pa1, pa2, pa3); pv_one<1>(o[1], vb, pa0, pa1, pa2, pa3); pv_one<2>(o[2], vb, pa0, pa1, pa2, pa3); pv_one<3>(o[3], vb, pa0, pa1, pa2, pa3);
}

__device__ __forceinline__ void attn_dense_body(const bf16* __restrict__ Qb, const bf16* __restrict__ Kh, const bf16* __restrict__ Vh,
                                                unsigned short* __restrict__ Zb, int seq, char* lds) {
  using TQ = bf16;
  using St = Stage<bf16>; using SQ = Stage<TQ>;
  const int tid = otid(), wid = tid >> 6, lane = tid & 63, r32 = lane & 31, hi = lane >> 5;
  bf16* V_lds = (bf16*)lds; bf16* K_lds = (bf16*)(lds + 2 * SHM_V);
  float* ws = (float*)(lds + 2 * SHM_V + 2 * SHM_K) + wid * 64; float* li_l = ws; float* al_l = ws + 32;
  float m_reg = -1e30f, l_reg = 0; f32x16 o[4] = {}; bf16x8 qr[8];
  const TQ* Qw = Qb + (long)(wid * QBLK + r32) * LDQ + hi * 8;
#pragma unroll
  for (int d0 = 0; d0 < 8; ++d0) qr[d0] = SQ::tobf(SQ::ld8(Qw + d0 * 16));
  const int sr = tid >> 4, sc = (tid & 15) * 8, vst0 = v_st(sr, sc), vst1 = v_st(32 + sr, sc);
  const int vb0 = (int)(uintptr_t)V_lds + v_rd_base(lane);
  struct { typename St::T vs0, vs1, ks0, ks1; } sr_[SDEPTH];
#define SLOAD(i, k0) do { sr_[i].vs0 = St::ld8(&Vh[(long)((k0) + sr) * LDK + sc]); sr_[i].vs1 = St::ld8(&Vh[(long)((k0) + 32 + sr) * LDK + sc]); \
    sr_[i].ks0 = St::ld8(&Kh[(long)((k0) + sr) * LDK + sc]); sr_[i].ks1 = St::ld8(&Kh[(long)((k0) + 32 + sr) * LDK + sc]); } while (0)
#define SWRITE(b, i) do { *(bf16x8*)((char*)V_lds + (b) * SHM_V + vst0) = St::tobf(sr_[i].vs0);          \
    *(bf16x8*)((char*)V_lds + (b) * SHM_V + vst1) = St::tobf(sr_[i].vs1); int kc = sc * 2;               \
    *(bf16x8*)((char*)K_lds + (b) * SHM_K + KSWZ(sr, kc)) = St::tobf(sr_[i].ks0);                       \
    *(bf16x8*)((char*)K_lds + (b) * SHM_K + KSWZ(32 + sr, kc)) = St::tobf(sr_[i].ks1); } while (0)
#define SWAIT() do { if constexpr (SDEPTH == 2) asm volatile("s_waitcnt vmcnt(4)" ::: "memory"); else asm volatile("s_waitcnt vmcnt(0)" ::: "memory"); } while (0)
#define RESC(a) do { if (__any((a) < 1.f)) { if (hi == 0) al_l[r32] = (a); asm volatile("s_waitcnt lgkmcnt(0)" ::: "memory"); \
    for (int d = 0; d < 4; ++d) for (int r = 0; r < 16; ++r) o[d][r] *= al_l[crow(r, hi)]; } } while (0)
  f32x16 pA0, pA1, pB0, pB1; float mnA, mnB, alA, alB; bf16x8 pa0, pa1, pa2, pa3; const int NT = seq / KVBLK;
  constexpr int SE = 0, SO = SDEPTH - 1;
  SLOAD(SE, 0); asm volatile("s_waitcnt vmcnt(0)" ::: "memory"); SWRITE(0, SE); __syncthreads();
  qkt(pA0, pA1, K_lds, qr, r32, hi); partialSM(pA0, pA1, m_reg, mnA, alA);
  SLOAD(SO, KVBLK); if constexpr (SDEPTH == 2) { if (2 < NT) SLOAD(SE, 2 * KVBLK); }
  SWAIT(); SWRITE(1, SO); __syncthreads();
  for (int j = 1; j + 1 < NT; j += 2) {
    SBAR(); qkt(pB0, pB1, (bf16*)((char*)K_lds + SHM_K), qr, r32, hi);
    finishSM(pA0, pA1, alA, l_reg, pa0, pa1, pa2, pa3); SBAR();
    SLOAD(SO, (j + SDEPTH) * KVBLK); SBAR();
    pv_d0(o, vb0, pa0, pa1, pa2, pa3); partialSM(pB0, pB1, m_reg, mnB, alB);
    __syncthreads(); SWAIT(); SWRITE(0, SE);
    RESC(alB); __syncthreads();
    SBAR(); qkt(pA0, pA1, K_lds, qr, r32, hi);
    finishSM(pB0, pB1, alB, l_reg, pa0, pa1, pa2, pa3); SBAR();
    if (SDEPTH == 1 || j + 3 < NT) SLOAD(SE, (j + 1 + SDEPTH) * KVBLK); SBAR();
    pv_d0(o, vb0 + (int)SHM_V, pa0, pa1, pa2, pa3); partialSM(pA0, pA1, m_reg, mnA, alA);
    __syncthreads(); SWAIT(); SWRITE(1, SO);
    RESC(alA); __syncthreads();
  }
  SBAR(); qkt(pB0, pB1, (bf16*)((char*)K_lds + SHM_K), qr, r32, hi);
  finishSM(pA0, pA1, alA, l_reg, pa0, pa1, pa2, pa3); SBAR();
  pv_d0(o, vb0, pa0, pa1, pa2, pa3); partialSM(pB0, pB1, m_reg, mnB, alB);
  __syncthreads(); RESC(alB);
  finishSM(pB0, pB1, alB, l_reg, pa0, pa1, pa2, pa3); SBAR();
  pv_d0(o, vb0 + (int)SHM_V, pa0, pa1, pa2, pa3);
  if (hi == 0) li_l[r32] = l_reg; asm volatile("s_waitcnt lgkmcnt(0)" ::: "memory");
  float rli[16];
#pragma unroll
  for (int r = 0; r < 16; ++r) rli[r] = __builtin_amdgcn_rcpf(li_l[crow(r, hi)]);
  unsigned short* Zw = Zb + (long)(wid * QBLK) * LDZ;
#pragma unroll
  for (int r = 0; r < 16; ++r) { int orow = crow(r, hi);
#pragma unroll
    for (int d0 = 0; d0 < 4; ++d0) { unsigned short* zp = Zw + (long)orow * LDZ + d0 * 32 + r32;
      const float z = __uint_as_float(((unsigned)*zp) << 16); const float val = o[d0][r] * rli[r] * (z / (1.f + __expf(-z)));
      unsigned u = __float_as_uint(val); *zp = (unsigned short)((u + 0x7fffu + ((u >> 16) & 1u)) >> 16); } }
#undef SLOAD
#undef SWRITE
#undef SWAIT
#undef RESC
}
#undef KSWZ
#undef SBAR
}
namespace pg8 {
#define PG8_LAS __attribute__((address_space(3)))
typedef unsigned short bf16_t;
typedef short bf16x8 __attribute__((ext_vector_type(8)));
typedef float f32x4 __attribute__((ext_vector_type(4)));
typedef unsigned u32x4 __attribute__((ext_vector_type(4)));
constexpr int BM = 256, BK = 64, HALF = 128, HTB = HALF * BK * 2  , STAGE_BYTES = 8 * HTB, NXCD = 8, WGM = 8;

__host__ __device__ __forceinline__ int lds_byte(int r, int c) { const int st = (r >> 4) * 2 + (c >> 5), rr = r & 15, cc = c & 31, ob = rr * 64 + cc * 2; return st * 1024 + (ob ^ (((ob >> 9) & 1) << 5)); }
__host__ __device__ __forceinline__ void stage_rc(int b, int& R, int& C) { const int st = b / 1024, sb = b % 1024, swz = sb ^ (((sb >> 9) & 1) << 5); R = (st >> 1) * 16 + swz / 64; C = (st & 1) * 32 + (swz % 64) / 2; }
__host__ __device__ __forceinline__ int perm32(int rho) { const int n = rho >> 4, i = rho & 15; return 8 * (i >> 2) + 4 * n + (i & 3); }

struct Unit { int pm, pn; };
struct Gemm { const bf16_t* A; const bf16_t* Bt; int M, N, K; };

struct StaticOrder {
    int nM, nN, nwg, G, c;
    __host__ __device__ void init(int M, int N, int G_, int c_) { nM = M / BM; nN = N / BM; nwg = nM * nN; G = G_; c = c_; }
    __host__ __device__ bool next(int i, Unit& u) const {
        const long L = (long)i * G + c; if (L >= nwg) return false;
        int wgid = (int)L; { const int q = nwg / NXCD, r = nwg % NXCD, xcd = wgid % NXCD, off = wgid / NXCD; wgid = (xcd < r ? xcd * (q + 1) : r * (q + 1) + (xcd - r) * q) + off; }
        const int nig = WGM * nN, gid = wgid / nig, fm = gid * WGM, gsz = (nM - fm) < WGM ? (nM - fm) : WGM;
        u.pm = fm + ((wgid % nig) % gsz); u.pn = (wgid % nig) / gsz; return true;
    }
    __device__ __forceinline__ void a_ready(const Unit&) const {}
    __device__ __forceinline__ void done(const Unit&) const {}
};

__device__ __forceinline__ unsigned cvt_pk_bf16(float lo, float hi) { unsigned r; asm volatile("v_cvt_pk_bf16_f32 %0, %1, %2" : "=v"(r) : "v"(lo), "v"(hi)); return r; }
struct EpiP {
    static constexpr bool PERM = true, AFTER_DRAIN = false;
    unsigned char* P; int tg;
    __device__ __forceinline__ void operator()(const f32x4 (&acc)[2][2][4][2], const Unit& u, int wr, int wc, int fr, int fq) const {
        const SubInfo si = sub_info(u.pn * BM);
        bf16_t* base = (bf16_t*)(P + (size_t)si.col0 * tg * 2);
        const int lc = u.pn * BM - si.col0 + wc * 32 + 8 * fq, row0 = u.pm * BM + wr * 64 + fr;
#pragma unroll
        for (int ai = 0; ai < 2; ++ai)
#pragma unroll
            for (int m = 0; m < 4; ++m) { bf16_t* rowp = base + (size_t)(row0 + ai * HALF + m * 16) * si.width + lc;
#pragma unroll
                for (int bj = 0; bj < 2; ++bj) { const f32x4 v0 = acc[ai][bj][m][0], v1 = acc[ai][bj][m][1];
                    u32x4 w; w.x = cvt_pk_bf16(v0[0], v0[1]); w.y = cvt_pk_bf16(v0[2], v0[3]); w.z = cvt_pk_bf16(v1[0], v1[1]); w.w = cvt_pk_bf16(v1[2], v1[3]);
                    *(u32x4*)(rowp + bj * HALF) = w; } }
    }
};
struct BrOrder {
    int ntile, G, c, tpg;
    __device__ __forceinline__ bool next(int i, Unit& u) const {
        const int tile = c + (i >> 2) * G; if (tile >= ntile) return false;
        const int br = i & 3; u.pm = br * tpg + (tile >> 2); u.pn = br * 4 + (tile & 3); return true;
    }
    __device__ __forceinline__ void a_ready(const Unit&) const {}
    __device__ __forceinline__ void done(const Unit&) const {}
};
struct EpiBr {
    static constexpr bool PERM = true, AFTER_DRAIN = false;
    const bf16_t* MG; float* Macc; bf16_t* merged; int tpg;
    __device__ __forceinline__ void operator()(const f32x4 (&acc)[2][2][4][2], const Unit& u, int wr, int wc, int fr, int fq) const {
        const int br = u.pn >> 2, pn = u.pn & 3, pm = u.pm - br * tpg;
        const int row0 = pm * BM + wr * 64 + fr, col0 = pn * BM + wc * 32 + 8 * fq;
#pragma unroll
        for (int ai = 0; ai < 2; ++ai)
#pragma unroll
            for (int m = 0; m < 4; ++m) { const size_t row = (size_t)(row0 + ai * HALF + m * 16);
#pragma unroll
                for (int bj = 0; bj < 2; ++bj) { const int col = col0 + bj * HALF;
                    const u32x4 gw = *(const u32x4*)(MG + row * 4096 + br * 1024 + col);
                    f32x4 v0 = acc[ai][bj][m][0], v1 = acc[ai][bj][m][1];
                    v0[0] *= sigm(bf2f(gw.x & 0xffffu)); v0[1] *= sigm(bf2f(gw.x >> 16)); v0[2] *= sigm(bf2f(gw.y & 0xffffu)); v0[3] *= sigm(bf2f(gw.y >> 16));
                    v1[0] *= sigm(bf2f(gw.z & 0xffffu)); v1[1] *= sigm(bf2f(gw.z >> 16)); v1[2] *= sigm(bf2f(gw.w & 0xffffu)); v1[3] *= sigm(bf2f(gw.w >> 16));
                    float* mp = Macc + row * 1024 + col;
                    if (br > 0) { v0 += *(const f32x4*)mp; v1 += *(const f32x4*)(mp + 4); }
                    if (br < 3) { *(f32x4*)mp = v0; *(f32x4*)(mp + 4) = v1; }
                    else { u32x4 w; w.x = cvt_pk_bf16(v0[0], v0[1]); w.y = cvt_pk_bf16(v0[2], v0[3]); w.z = cvt_pk_bf16(v1[0], v1[1]); w.w = cvt_pk_bf16(v1[2], v1[3]);
                        *(u32x4*)(merged + row * 1024 + col) = w; } } }
    }
};
struct EpiOut {
    static constexpr bool PERM = true, AFTER_DRAIN = false;
    Params p; float* hpre; int l, g;
    __device__ __forceinline__ void operator()(const f32x4 (&acc)[2][2][4][2], const Unit& u, int wr, int wc, int fr, int fq) const {
        const int row0 = u.pm * BM + wr * 64 + fr, col0 = u.pn * BM + wc * 32 + 8 * fq;
        const float* mod = (const float*)(p.ws + WS_MOD);
#pragma unroll
        for (int ai = 0; ai < 2; ++ai)
#pragma unroll
            for (int m = 0; m < 4; ++m) { const int row = row0 + ai * HALF + m * 16, grow = g * p.tg + row, b = grow / TPB, s = grow % TPB;
                const float* hr = h_in_row(p, l, grow); const float* gt = mod + ((size_t)l * 9 + (s < CTX ? 8 : b)) * 3072 + 2048;
#pragma unroll
                for (int bj = 0; bj < 2; ++bj) { const int col = col0 + bj * HALF;
                    const f32x4 h0 = *(const f32x4*)(hr + col), h1 = *(const f32x4*)(hr + col + 4), g0 = *(const f32x4*)(gt + col), g1 = *(const f32x4*)(gt + col + 4);
                    float* op = hpre + (size_t)row * 1024 + col;
                    *(f32x4*)op = h0 * ALPHA + g0 * acc[ai][bj][m][0]; *(f32x4*)(op + 4) = h1 * ALPHA + g1 * acc[ai][bj][m][1]; } }
    }
};
template <class Epi, class Sched, bool ALIGN_EPI = false, bool SP2 = false>
__device__ __forceinline__ void gemm_phase(PG8_LAS unsigned char* lds, const Gemm g, const Sched& S, const Epi& E) {
    const int tid = otid(), wid = __builtin_amdgcn_readfirstlane(tid >> 6), lane = tid & 63, wr = wid >> 2, wc = wid & 3, fr = lane & 15, fq = lane >> 4;
    const int K = g.K, nt = K / BK;
    unsigned voffA[2], voffB[2];
#pragma unroll
    for (int i = 0; i < 2; ++i) { int R, C; stage_rc(tid * 16 + i * 8192, R, C); const int Rb = Epi::PERM ? ((R & ~31) + perm32(R & 31)) : R;
        voffA[i] = (unsigned)(R * K + C) * 2u; voffB[i] = (unsigned)(Rb * K + C) * 2u; }
    const size_t kstep = (size_t)(BK * 2);
    const size_t hstep = (size_t)HALF * K * 2;
    const size_t tstep = 2 * hstep;
    const unsigned ldsw = (unsigned)wid * 1024u;
    const int aoff = lds_byte(wr * 64 + fr, fq * 8), boff = lds_byte(wc * 32 + fr, fq * 8);
#define PG8_SA(b, h) (((b) * 2 + (h)) * HTB)
#define PG8_SB(b, h) ((4 + (b) * 2 + (h)) * HTB)
#define PG8_STAGE(bufoff, gbase, voff) do { _Pragma("unroll") for (int _i = 0; _i < 2; ++_i) \
        __builtin_amdgcn_global_load_lds((const unsigned*)((const char*)(gbase) + (voff)[_i]), (PG8_LAS unsigned*)(lds + (bufoff) + ldsw + _i * 8192), 16, 0, 0); } while (0)
#define PG8_LDA(dst, b, h) do { _Pragma("unroll") for (int m = 0; m < 4; ++m) _Pragma("unroll") for (int k = 0; k < 2; ++k) dst[m][k] = *(const PG8_LAS bf16x8*)(lds + PG8_SA(b, h) + aoff + m * 2048 + k * 1024); } while (0)
#define PG8_LDB(dst, b, h) do { _Pragma("unroll") for (int n = 0; n < 2; ++n) _Pragma("unroll") for (int k = 0; k < 2; ++k) dst[n][k] = *(const PG8_LAS bf16x8*)(lds + PG8_SB(b, h) + boff + n * 2048 + k * 1024); } while (0)
#define PG8_MMA(ai, bj, At, Bt) do { __builtin_amdgcn_s_setprio(1); _Pragma("unroll") for (int m = 0; m < 4; ++m) _Pragma("unroll") for (int n = 0; n < 2; ++n) _Pragma("unroll") for (int k = 0; k < 2; ++k) \
        acc[ai][bj][m][n] = __builtin_amdgcn_mfma_f32_16x16x32_bf16(Bt[n][k], At[m][k], acc[ai][bj][m][n], 0, 0, 0); __builtin_amdgcn_s_setprio(0); } while (0)
#define PG8_WAIT_V(n) asm volatile("s_waitcnt vmcnt(" #n ")" ::: "memory")
#define PG8_WAIT_L(n) asm volatile("s_waitcnt lgkmcnt(" #n ")" ::: "memory")
#define PG8_BAR __builtin_amdgcn_s_barrier()
#define PG8_SCHED __builtin_amdgcn_sched_barrier(0)
    Unit cur, nxt; int ui = 0;
    if (!S.next(0, cur)) return;
    f32x4 acc[2][2][4][2];
#pragma unroll
    for (int a = 0; a < 2; ++a)
#pragma unroll
        for (int b = 0; b < 2; ++b)
#pragma unroll
            for (int m = 0; m < 4; ++m)
#pragma unroll
                for (int n = 0; n < 2; ++n) acc[a][b][m][n] = (f32x4){0.f, 0.f, 0.f, 0.f};
    bf16x8 At[4][2], B0[2][2], B1[2][2];
    const char* cA = (const char*)g.A + (size_t)cur.pm * tstep; const char* cB = (const char*)g.Bt + (size_t)cur.pn * tstep;
    S.a_ready(cur);
    if constexpr (SP2) {
        PG8_STAGE(PG8_SB(0, 0), cB, voffB); PG8_STAGE(PG8_SB(0, 1), cB + hstep, voffB); PG8_STAGE(PG8_SA(0, 0), cA, voffA); PG8_STAGE(PG8_SA(0, 1), cA + hstep, voffA);
        if (wr == 1) PG8_BAR;
        PG8_WAIT_V(2); PG8_BAR;
        PG8_STAGE(PG8_SB(1, 0), cB + kstep, voffB); PG8_STAGE(PG8_SA(1, 0), cA + kstep, voffA); PG8_STAGE(PG8_SB(1, 1), cB + hstep + kstep, voffB);
        PG8_WAIT_V(6); PG8_BAR;
    } else {
        PG8_STAGE(PG8_SB(0, 0), cB, voffB); PG8_STAGE(PG8_SA(0, 0), cA, voffA); PG8_STAGE(PG8_SB(0, 1), cB + hstep, voffB); PG8_STAGE(PG8_SA(0, 1), cA + hstep, voffA);
        if (wr == 1) PG8_BAR;
        PG8_WAIT_V(4); PG8_BAR;
        PG8_STAGE(PG8_SB(1, 0), cB + kstep, voffB); PG8_STAGE(PG8_SA(1, 0), cA + kstep, voffA); PG8_STAGE(PG8_SB(1, 1), cB + hstep + kstep, voffB);
        PG8_WAIT_V(6); PG8_BAR;
    }
    for (;;) {
        const bool has_next = S.next(ui + 1, nxt);
        const char* nA = has_next ? (const char*)g.A + (size_t)nxt.pm * tstep : cA; const char* nB = has_next ? (const char*)g.Bt + (size_t)nxt.pn * tstep : cB;
        for (int t = 0; t < nt; t += 2) {
            const bool last = (t == nt - 2);
            const char* a1 = cA + (size_t)(t + 1) * kstep;
            const char* a2 = last ? nA : cA + (size_t)(t + 2) * kstep; const char* b2 = last ? nB : cB + (size_t)(t + 2) * kstep;
            const char* a3 = a2 + kstep; const char* b3 = b2 + kstep;
            if (last && has_next) S.a_ready(nxt);
            if constexpr (SP2) {
            PG8_LDB(B0, 0, 0); PG8_LDB(B1, 0, 1); PG8_SCHED; PG8_LDA(At, 0, 0); PG8_STAGE(PG8_SA(1, 1), a1 + hstep, voffA);
            PG8_WAIT_V(8); PG8_WAIT_L(0); PG8_BAR; PG8_MMA(0, 0, At, B0); PG8_MMA(0, 1, At, B1); PG8_BAR; PG8_SCHED;
            PG8_LDA(At, 0, 1); PG8_STAGE(PG8_SB(0, 0), b2, voffB); PG8_STAGE(PG8_SB(0, 1), b2 + hstep, voffB); PG8_STAGE(PG8_SA(0, 0), a2, voffA);
            PG8_WAIT_V(8); PG8_WAIT_L(0); PG8_BAR; PG8_MMA(1, 0, At, B0); PG8_MMA(1, 1, At, B1); PG8_BAR; PG8_SCHED;
            PG8_LDB(B0, 1, 0); PG8_LDB(B1, 1, 1); PG8_SCHED; PG8_LDA(At, 1, 0); PG8_STAGE(PG8_SA(0, 1), a2 + hstep, voffA);
            PG8_WAIT_V(8); PG8_WAIT_L(0); PG8_BAR; PG8_MMA(0, 0, At, B0); PG8_MMA(0, 1, At, B1); PG8_BAR; PG8_SCHED;
            PG8_LDA(At, 1, 1); PG8_STAGE(PG8_SB(1, 0), b3, voffB); PG8_STAGE(PG8_SB(1, 1), b3 + hstep, voffB); PG8_STAGE(PG8_SA(1, 0), a3, voffA);
            PG8_WAIT_V(8); PG8_WAIT_L(0); PG8_BAR; PG8_MMA(1, 0, At, B0); PG8_MMA(1, 1, At, B1); PG8_BAR; PG8_SCHED;
            } else {
            PG8_LDB(B0, 0, 0); PG8_SCHED; PG8_LDA(At, 0, 0); PG8_STAGE(PG8_SA(1, 1), a1 + hstep, voffA);
            PG8_WAIT_L(8); PG8_BAR; PG8_WAIT_L(0); PG8_MMA(0, 0, At, B0); PG8_BAR; PG8_SCHED;
            PG8_LDB(B1, 0, 1); PG8_STAGE(PG8_SB(0, 0), b2, voffB);
            PG8_BAR; PG8_WAIT_L(0); PG8_MMA(0, 1, At, B1); PG8_BAR;
            PG8_LDA(At, 0, 1); PG8_STAGE(PG8_SA(0, 0), a2, voffA);
            PG8_BAR; PG8_WAIT_L(0); PG8_MMA(1, 0, At, B0); PG8_BAR; PG8_SCHED;
            PG8_STAGE(PG8_SB(0, 1), b2 + hstep, voffB);
            PG8_WAIT_V(6); PG8_BAR; PG8_MMA(1, 1, At, B1); PG8_BAR;
            PG8_LDB(B0, 1, 0); PG8_SCHED; PG8_LDA(At, 1, 0); PG8_STAGE(PG8_SA(0, 1), a2 + hstep, voffA);
            PG8_WAIT_L(8); PG8_BAR; PG8_WAIT_L(0); PG8_MMA(0, 0, At, B0); PG8_BAR; PG8_SCHED;
            PG8_LDB(B1, 1, 1); PG8_STAGE(PG8_SB(1, 0), b3, voffB);
            PG8_BAR; PG8_WAIT_L(0); PG8_MMA(0, 1, At, B1); PG8_BAR;
            PG8_LDA(At, 1, 1); PG8_STAGE(PG8_SA(1, 0), a3, voffA);
            PG8_BAR; PG8_WAIT_L(0); PG8_MMA(1, 0, At, B0); PG8_BAR; PG8_SCHED;
            PG8_STAGE(PG8_SB(1, 1), b3 + hstep, voffB);
            PG8_WAIT_V(6); PG8_BAR; PG8_MMA(1, 1, At, B1); PG8_BAR;
            }
        }
        if constexpr (ALIGN_EPI) { if (wr == 0) PG8_BAR; }
        if constexpr (!Epi::AFTER_DRAIN) { E(acc, cur, wr, wc, fr, fq); S.done(cur); }
        if (!has_next) break;
#pragma unroll
        for (int a = 0; a < 2; ++a)
#pragma unroll
            for (int b = 0; b < 2; ++b)
#pragma unroll
                for (int m = 0; m < 4; ++m)
#pragma unroll
                    for (int n = 0; n < 2; ++n) acc[a][b][m][n] = (f32x4){0.f, 0.f, 0.f, 0.f};
        cur = nxt; cA = nA; cB = nB; ++ui;
        if constexpr (ALIGN_EPI) { if (wr == 1) PG8_BAR; }
    }
    PG8_WAIT_V(0);
    if constexpr (!ALIGN_EPI) { if (wr == 0) PG8_BAR; }
    PG8_BAR;
    if constexpr (Epi::AFTER_DRAIN) { E.fused(acc, cur, wr, wc, fr, fq, lds, wid, lane); S.done(cur); }
#undef PG8_SA
#undef PG8_SB
#undef PG8_STAGE
#undef PG8_LDA
#undef PG8_LDB
#undef PG8_MMA
#undef PG8_WAIT_V
#undef PG8_WAIT_L
#undef PG8_BAR
#undef PG8_SCHED
}
}
__device__ __forceinline__ void transpose_tile(const float* __restrict__ src, int pitch_src, int nvalid, bf16_t* __restrict__ dst, int pitch_dst, float* tile) {
    const int t = otid(), r = t >> 3, c8 = (t & 7) * 8;
    if (c8 < nvalid) {
        const f32x4 a = *(const f32x4*)(src + (size_t)r * pitch_src + c8), b = *(const f32x4*)(src + (size_t)r * pitch_src + c8 + 4);
        float* tp = tile + r * 65 + c8;
        tp[0] = a[0]; tp[1] = a[1]; tp[2] = a[2]; tp[3] = a[3]; tp[4] = b[0]; tp[5] = b[1]; tp[6] = b[2]; tp[7] = b[3];
    }
    __syncthreads();
    if (r < nvalid) {
        u32x4 w;
        w.x = pk2(tile[(c8 + 0) * 65 + r], tile[(c8 + 1) * 65 + r]); w.y = pk2(tile[(c8 + 2) * 65 + r], tile[(c8 + 3) * 65 + r]);
        w.z = pk2(tile[(c8 + 4) * 65 + r], tile[(c8 + 5) * 65 + r]); w.w = pk2(tile[(c8 + 6) * 65 + r], tile[(c8 + 7) * 65 + r]);
        *(u32x4*)(dst + (size_t)r * pitch_dst + c8) = w;
    }
    __syncthreads();
}
__device__ __forceinline__ void mod_item(const Params& p, int item, unsigned char* lds) {
    const int l = item / 48, cb = item % 48, t = otid(), lane = t & 63, w = t >> 6;
    float* sc = (float*)lds; float* red = sc + 9 * 1024;
    for (int i = t; i < 9 * 1024; i += 512) { const int b = i >> 10, k = i & 1023; const float v = b < 8 ? p.c[b * 1024 + k] : p.c_ctx[k]; sc[i] = silu(v); }
    __syncthreads();
    const float* wm = p.w_mod + (size_t)l * 1024 * 3072 + cb * 64 + lane;
    float acc[9];
#pragma unroll
    for (int b = 0; b < 9; ++b) acc[b] = 0.f;
#pragma unroll 4
    for (int k = w * 128; k < w * 128 + 128; ++k) { const float wv = wm[(size_t)k * 3072];
#pragma unroll
        for (int b = 0; b < 9; ++b) acc[b] += sc[b * 1024 + k] * wv; }
#pragma unroll
    for (int b = 0; b < 9; ++b) red[(w * 9 + b) * 64 + lane] = acc[b];
    __syncthreads();
    float* mod = (float*)(p.ws + WS_MOD);
    for (int i = t; i < 576; i += 512) { const int b = i >> 6, c = i & 63; float s = 0.f;
#pragma unroll
        for (int w2 = 0; w2 < 8; ++w2) s += red[(w2 * 9 + b) * 64 + c];
        mod[((size_t)l * 9 + b) * 3072 + cb * 64 + c] = s + p.b_mod[l * 3072 + cb * 64 + c]; }
    __syncthreads();
}
__device__ __forceinline__ void phase0(const Params& p, unsigned char* lds) {
    constexpr int N_WIN = 2 * 168 * 16, N_R = 32, N_BR = 1024, N_OUT = 512, N_MOD = 96, N_ALL = N_WIN + N_R + N_BR + N_OUT + N_MOD;
    float* tile = (float*)lds;
    bf16_t* Win_t = (bf16_t*)(p.ws + WS_WIN); bf16_t* Wr_t = (bf16_t*)(p.ws + WS_WR); bf16_t* Wbr_t = (bf16_t*)(p.ws + WS_WBR); bf16_t* Wout_t = (bf16_t*)(p.ws + WS_WOUT);
    for (int it0 = blockIdx.x; it0 < N_ALL; it0 += gridDim.x) {
        int it = it0;
        if (it < N_MOD) { mod_item(p, it, lds); continue; }
        it -= N_MOD;
        if (it < N_WIN) { const int l = it / 2688, rem = it % 2688, nt = rem / 16, kt = rem % 16, n0 = nt * 64; const SubInfo si = sub_info(n0);
            transpose_tile(p.w_in + (size_t)l * 1024 * WIN_COLS + (size_t)(kt * 64) * WIN_COLS + si.orig0 + (n0 - si.col0), WIN_COLS, 64,
                           Win_t + (size_t)l * NCOL * 1024 + (size_t)n0 * 1024 + kt * 64, 1024, tile); continue; }
        it -= N_WIN;
        if (it < N_R) { const int l = it / 16, kt = it % 16;
            transpose_tile(p.w_in + (size_t)l * 1024 * WIN_COLS + (size_t)(kt * 64) * WIN_COLS + 5120, WIN_COLS, 32, Wr_t + (size_t)l * 32 * 1024 + kt * 64, 1024, tile); continue; }
        it -= N_R;
        if (it < N_BR) { const int li = it / 128, rem = it % 128, kt = rem / 16, nt = rem % 16;
            transpose_tile(p.w_br + ((size_t)li * 512 + kt * 64) * 1024 + nt * 64, 1024, 64, Wbr_t + ((size_t)li * 1024 + nt * 64) * 512 + kt * 64, 512, tile); continue; }
        it -= N_BR;
        { const int l = it / 256, rem = it % 256, kt = rem / 16, nt = rem % 16;
            transpose_tile(p.w_out + ((size_t)l * 1024 + kt * 64) * 1024 + nt * 64, 1024, 64, Wout_t + ((size_t)l * 1024 + nt * 64) * 1024 + kt * 64, 1024, tile); }
    }
}

__device__ __forceinline__ void ln_phase(const Params& p, int mode, int l, int lu, int row0, int nrows, const float* __restrict__ hpre) {
    const int tid_ = otid(), lane = tid_ & 63, w = tid_ >> 6;
    const float* mod = (const float*)(p.ws + WS_MOD); bf16_t* U = (bf16_t*)(p.ws + WS_U); float* hctx = (float*)(p.ws + WS_HCTX);
    for (int rr = blockIdx.x * 8 + w; rr < nrows; rr += gridDim.x * 8) {
        const int grow = row0 + rr, b = grow / TPB, s = grow % TPB; const bool isctx = s < CTX;
        if (mode == 2 && isctx) continue;
        const float* src = mode == 0 ? h_in_row(p, 0, grow) : hpre + (size_t)rr * 1024;
        f32x4 v[4];
#pragma unroll
        for (int q = 0; q < 4; ++q) v[q] = *(const f32x4*)(src + q * 256 + lane * 4);
        float s1 = 0.f;
#pragma unroll
        for (int q = 0; q < 4; ++q) s1 += (v[q][0] + v[q][1]) + (v[q][2] + v[q][3]);
        float mean = wave_sum(s1) * (1.f / 1024.f), s2 = 0.f;
#pragma unroll
        for (int q = 0; q < 4; ++q) { const f32x4 d = v[q] - mean; s2 += (d[0] * d[0] + d[1] * d[1]) + (d[2] * d[2] + d[3] * d[3]); }
        float rstd = rsqrtf(wave_sum(s2) * (1.f / 1024.f) + EPS);
        if (mode != 0) {
            float* hdst = isctx ? hctx + ((size_t)b * CTX + s) * 1024 : p.out + ((size_t)b * SEQ + (s - CTX)) * 1024;
#pragma unroll
            for (int q = 0; q < 4; ++q) { const int col = q * 256 + lane * 4;
                const f32x4 gg = *(const f32x4*)(p.ln_g + l * 1024 + col), bb = *(const f32x4*)(p.ln_b + l * 1024 + col);
                v[q] = (v[q] - mean) * rstd * gg + bb; *(f32x4*)(hdst + col) = v[q]; }
            if (mode == 2) continue;
            s1 = 0.f;
#pragma unroll
            for (int q = 0; q < 4; ++q) s1 += (v[q][0] + v[q][1]) + (v[q][2] + v[q][3]);
            mean = wave_sum(s1) * (1.f / 1024.f); s2 = 0.f;
#pragma unroll
            for (int q = 0; q < 4; ++q) { const f32x4 d = v[q] - mean; s2 += (d[0] * d[0] + d[1] * d[1]) + (d[2] * d[2] + d[3] * d[3]); }
            rstd = rsqrtf(wave_sum(s2) * (1.f / 1024.f) + EPS);
        }
        const float* md = mod + ((size_t)lu * 9 + (isctx ? 8 : b)) * 3072;
#pragma unroll
        for (int q = 0; q < 4; ++q) { const int col = q * 256 + lane * 4;
            const f32x4 sh = *(const f32x4*)(md + col), scl = *(const f32x4*)(md + 1024 + col);
            const f32x4 uu = (v[q] - mean) * rstd * (scl + 1.f) + sh;
            uint2 o; o.x = pk2(uu[0], uu[1]); o.y = pk2(uu[2], uu[3]);
            *(uint2*)(U + (size_t)grow * 1024 + col) = o; }
    }
}

__device__ __forceinline__ void r_items(const Params& p, int l, int g) {
    const int tid_ = otid(), lane = tid_ & 63, w = tid_ >> 6, fr = lane & 15, fq = lane >> 4, tg = p.tg;
    const bf16_t* U = (const bf16_t*)(p.ws + WS_U) + (size_t)g * tg * 1024; float* R = (float*)(p.ws + WS_R) + (size_t)g * tg * 32;
    const bf16_t* W = (const bf16_t*)(p.ws + WS_WR) + (size_t)l * 32 * 1024;
    for (int it = blockIdx.x * 8 + w; it < tg / 16; it += gridDim.x * 8) {
        f32x4 a0 = {0.f, 0.f, 0.f, 0.f}, a1 = {0.f, 0.f, 0.f, 0.f};
        const bf16_t* up = U + (size_t)(it * 16 + fr) * 1024 + fq * 8; const bf16_t* w0 = W + fr * 1024 + fq * 8; const bf16_t* w1 = W + (16 + fr) * 1024 + fq * 8;
#pragma unroll 4
        for (int ks = 0; ks < 32; ++ks) {
            const bf16x8 a = *(const bf16x8*)(up + ks * 32), b0 = *(const bf16x8*)(w0 + ks * 32), b1 = *(const bf16x8*)(w1 + ks * 32);
            a0 = __builtin_amdgcn_mfma_f32_16x16x32_bf16(a, b0, a0, 0, 0, 0); a1 = __builtin_amdgcn_mfma_f32_16x16x32_bf16(a, b1, a1, 0, 0, 0);
        }
#pragma unroll
        for (int jj = 0; jj < 4; ++jj) { float* rp = R + (size_t)(it * 16 + fq * 4 + jj) * 32; rp[fr] = a0[jj]; rp[16 + fr] = a1[jj]; }
    }
}
__device__ __forceinline__ void qk_prep(const Params& p, int l) {
    const int tid_ = otid(), lane = tid_ & 63, w = tid_ >> 6, tg = p.tg;
    bf16_t* Aq = subbuf(p, C_AQ); bf16_t* Ak = subbuf(p, C_AK);
    const float qg0 = p.q_norm[l * 128 + 2 * lane], qg1 = p.q_norm[l * 128 + 2 * lane + 1], kg0 = p.k_norm[l * 128 + 2 * lane], kg1 = p.k_norm[l * 128 + 2 * lane + 1];
    const float inv = exp2f(-(float)(lane & 31) * (13.287712379549449f / 32.f)) * 0.15915494309189535f;
    for (int row = blockIdx.x * 8 + w; row < tg; row += gridDim.x * 8) {
        const int s = row % TPB; float cs = 1.f, sn = 0.f;
        if (s >= CTX) { const int t = s - CTX; const int pos = lane < 32 ? (t >> 6) : (t & 63); float rev = (float)pos * inv; rev -= floorf(rev);
            sn = __builtin_amdgcn_sinf(rev); cs = __builtin_amdgcn_cosf(rev); }
#pragma unroll
        for (int hh = 0; hh < 6; ++hh) {
            bf16_t* ptr = hh < 4 ? Aq + (size_t)row * 512 + hh * 128 + 2 * lane : Ak + (size_t)row * 256 + (hh - 4) * 128 + 2 * lane;
            const unsigned pr = *(const unsigned*)ptr; const float x0 = bf2f(pr & 0xffffu), x1 = bf2f(pr >> 16);
            const float ss = wave_sum(x0 * x0 + x1 * x1), rinv = rsqrtf(ss * (1.f / 128.f) + EPS);
            const float y0 = x0 * rinv * (hh < 4 ? qg0 : kg0), y1 = x1 * rinv * (hh < 4 ? qg1 : kg1);
            *(unsigned*)ptr = pk2(y0 * cs - y1 * sn, y0 * sn + y1 * cs);
        }
    }
}
__device__ __forceinline__ void short_conv(const Params& p, int l) {
    const int tg = p.tg; const bf16_t* Bg = subbuf(p, C_BG); const bf16_t* Cg = subbuf(p, C_CG); const bf16_t* Xin = subbuf(p, C_XIN); bf16_t* Zb = subbuf(p, C_ZB);
    const float* wv = p.b_conv + l * 3 * 512;
    const int tid_ = otid();
    for (int idx = blockIdx.x * 512 + tid_; idx < tg * 64; idx += gridDim.x * 512) {
        const int row = idx >> 6, c8 = (idx & 63) * 8, s = row % TPB; const size_t o = (size_t)row * 512 + c8;
        const bool hp = (s != 0 && s != CTX), hn = (s != CTX - 1 && s != TPB - 1);
        const u32x4 zero = {0u, 0u, 0u, 0u};
        const u32x4 bg = *(const u32x4*)(Bg + o), zb = *(const u32x4*)(Zb + o), c1 = *(const u32x4*)(Cg + o), x1 = *(const u32x4*)(Xin + o);
        const u32x4 c0 = hp ? *(const u32x4*)(Cg + o - 512) : zero, x0 = hp ? *(const u32x4*)(Xin + o - 512) : zero;
        const u32x4 c2 = hn ? *(const u32x4*)(Cg + o + 512) : zero, x2 = hn ? *(const u32x4*)(Xin + o + 512) : zero;
        u32x4 ow;
#pragma unroll
        for (int e = 0; e < 4; ++e) {
            float res[2];
#pragma unroll
            for (int hl = 0; hl < 2; ++hl) { const int c = c8 + 2 * e + hl; const int sh = hl * 16;
                const float p0 = bf2f((c0[e] >> sh) & 0xffffu) * bf2f((x0[e] >> sh) & 0xffffu), p1 = bf2f((c1[e] >> sh) & 0xffffu) * bf2f((x1[e] >> sh) & 0xffffu),
                            p2 = bf2f((c2[e] >> sh) & 0xffffu) * bf2f((x2[e] >> sh) & 0xffffu);
                const float cv = wv[c] * p0 + wv[512 + c] * p1 + wv[1024 + c] * p2;
                res[hl] = bf2f((bg[e] >> sh) & 0xffffu) * cv * silu(bf2f((zb[e] >> sh) & 0xffffu)); }
            ow[e] = pk2(res[0], res[1]);
        }
        *(u32x4*)(Zb + o) = ow;
    }
}
__device__ __forceinline__ void conformer(const Params& p, int l, unsigned char* lds) {
    const int tg = p.tg, c = otid(), lane = c & 63, w = c >> 6;
    float* hbuf = (float*)lds;
    const bf16_t* Glu = subbuf(p, C_GLU); bf16_t* Zd = subbuf(p, C_ZD);
    float wk[31];
#pragma unroll
    for (int k = 0; k < 31; ++k) wk[k] = p.d_conv_w[((size_t)l * 31 + k) * 512 + c];
    const float bias = p.d_conv_b[l * 512 + c];
    for (int it = blockIdx.x; it < tg / 16; it += gridDim.x) {
        const int r0 = it * 16, s0 = r0 % TPB, bstart = r0 - s0;
        const int seg_lo = s0 < CTX ? bstart : bstart + CTX, seg_hi = s0 < CTX ? bstart + CTX : bstart + TPB;
        float v[46];
#pragma unroll
        for (int i = 0; i < 46; ++i) { const int row = r0 - 15 + i; float val = 0.f;
            if (row >= seg_lo && row < seg_hi) { const float a = bf2f(Glu[(size_t)row * 1024 + c]), gt = bf2f(Glu[(size_t)row * 1024 + 512 + c]); val = a * sigm(gt); }
            v[i] = val; }
#pragma unroll
        for (int t = 0; t < 16; ++t) { float hh = bias;
#pragma unroll
            for (int k = 0; k < 31; ++k) hh += wk[k] * v[t + k];
            hbuf[t * 512 + c] = hh; }
        __syncthreads();
#pragma unroll
        for (int tt = 0; tt < 2; ++tt) { const int t = 2 * w + tt, c8 = lane * 8;
            const f32x4 a = *(const f32x4*)(hbuf + t * 512 + c8), b = *(const f32x4*)(hbuf + t * 512 + c8 + 4);
            const float mean = wave_sum((a[0] + a[1]) + (a[2] + a[3]) + (b[0] + b[1]) + (b[2] + b[3])) * (1.f / 512.f);
            const f32x4 da = a - mean, db = b - mean;
            const float var = wave_sum((da[0] * da[0] + da[1] * da[1]) + (da[2] * da[2] + da[3] * da[3]) + (db[0] * db[0] + db[1] * db[1]) + (db[2] * db[2] + db[3] * db[3])) * (1.f / 512.f);
            const float rstd = rsqrtf(var + EPS);
            const float* gp = p.d_norm_g + l * 512 + c8; const float* bp = p.d_norm_b + l * 512 + c8;
            const f32x4 g0 = *(const f32x4*)gp, g1 = *(const f32x4*)(gp + 4), b0 = *(const f32x4*)bp, b1 = *(const f32x4*)(bp + 4);
            const f32x4 y0 = da * rstd * g0 + b0, y1 = db * rstd * g1 + b1;
            bf16_t* zp = Zd + (size_t)(r0 + t) * 512 + c8; const u32x4 zw = *(const u32x4*)zp;
            u32x4 ow;
            ow.x = pk2(silu(y0[0]) * silu(bf2f(zw.x & 0xffffu)), silu(y0[1]) * silu(bf2f(zw.x >> 16)));
            ow.y = pk2(silu(y0[2]) * silu(bf2f(zw.y & 0xffffu)), silu(y0[3]) * silu(bf2f(zw.y >> 16)));
            ow.z = pk2(silu(y1[0]) * silu(bf2f(zw.z & 0xffffu)), silu(y1[1]) * silu(bf2f(zw.z >> 16)));
            ow.w = pk2(silu(y1[2]) * silu(bf2f(zw.w & 0xffffu)), silu(y1[3]) * silu(bf2f(zw.w >> 16)));
            *(u32x4*)zp = ow; }
        __syncthreads();
    }
}
#define GLA_PT 72
__device__ __forceinline__ void gla_chain(const Params& p, int l, int g, int bl, int h, int dir, bool skip_ctx_out, unsigned char* lds) {
    const int tid = otid(), lane = tid & 63, w = tid >> 6, fr = lane & 15, fq = lane >> 4, tg = p.tg, d = lane;
    const bf16_t* Cq = subbuf(p, C_CQ); const bf16_t* Ck = subbuf(p, C_CK); const bf16_t* Cv = subbuf(p, C_CV);
    const float* R = (const float*)(p.ws + WS_R) + (size_t)g * tg * 32;
    float* Op = (float*)(p.ws + WS_P) + (size_t)dir * tg * 512;
    bf16_t* Qt = (bf16_t*)lds; bf16_t* Kt = Qt + 64 * GLA_PT; bf16_t* Kht = Kt + 64 * GLA_PT; bf16_t* As = Kht + 64 * GLA_PT; bf16_t* Vt = As + 64 * GLA_PT; bf16_t* St = Vt + 128 * GLA_PT;
    float* rl = (float*)(St + 128 * GLA_PT); float* segtot = rl + 1024; float* el = segtot + 512;
    float w2c[16];
#pragma unroll
    for (int m = 0; m < 16; ++m) w2c[m] = p.c_gate_w2[(((size_t)l * 2 + dir) * 16 + m) * 256 + h * 64 + d];
    const float b2 = p.c_gate_b[((size_t)l * 2 + dir) * 256 + h * 64 + d];
    f32x4 Sacc[4];
#pragma unroll
    for (int i = 0; i < 4; ++i) Sacc[i] = (f32x4){0.f, 0.f, 0.f, 0.f};
    const int rb = bl * TPB;
    unsigned short qn[8], kn[8]; u32x4 vn[2]; f32x4 rn = {0.f, 0.f, 0.f, 0.f};
#define GLA_CHUNK(s) (dir == 0 ? (s) : ((s) < 4 ? 3 - (s) : 39 - (s)))
#define GLA_ROW(base, i) ((base) + (dir ? 63 - (i) : (i)))
#define GLA_LOAD(s) do { const int _base = rb + GLA_CHUNK(s) * 64; \
        _Pragma("unroll") for (int e = 0; e < 8; ++e) { const size_t _row = (size_t)GLA_ROW(_base, w * 8 + e); qn[e] = Cq[_row * 256 + h * 64 + d]; kn[e] = Ck[_row * 256 + h * 64 + d]; } \
        _Pragma("unroll") for (int u2 = 0; u2 < 2; ++u2) { const int _idx = tid + 512 * u2; const size_t _row = (size_t)GLA_ROW(_base, _idx >> 4); vn[u2] = *(const u32x4*)(Cv + _row * 512 + h * 128 + (_idx & 15) * 8); } \
        if (tid < 256) { const size_t _row = (size_t)GLA_ROW(_base, tid >> 2); rn = *(const f32x4*)(R + _row * 32 + dir * 16 + (tid & 3) * 4); } } while (0)
    GLA_LOAD(0);
    for (int s = 0; s < 36; ++s) {
        const int c = GLA_CHUNK(s), base = rb + c * 64;
        if (tid < 256) *(f32x4*)(rl + (tid >> 2) * 16 + (tid & 3) * 4) = rn;
        float qc[8], kc[8]; u32x4 vc[2];
#pragma unroll
        for (int e = 0; e < 8; ++e) { qc[e] = bf2f(qn[e]); kc[e] = bf2f(kn[e]); }
        vc[0] = vn[0]; vc[1] = vn[1];
        if (s + 1 < 36) GLA_LOAD(s + 1);
        __syncthreads();
        float cum[8], run = 0.f;
#pragma unroll
        for (int e = 0; e < 8; ++e) { const float* rp = rl + (w * 8 + e) * 16; float z = b2;
#pragma unroll
            for (int m4 = 0; m4 < 4; ++m4) { const f32x4 rv = *(const f32x4*)(rp + m4 * 4); z += rv[0] * w2c[m4 * 4] + rv[1] * w2c[m4 * 4 + 1] + rv[2] * w2c[m4 * 4 + 2] + rv[3] * w2c[m4 * 4 + 3]; }
            const float gl = (fminf(z, 0.f) - __logf(1.f + __expf(-fabsf(z)))) * (1.f / 16.f);
            run += gl; cum[e] = run; }
        segtot[w * 64 + d] = run;
        __syncthreads();
        float off = 0.f, tot = 0.f;
#pragma unroll
        for (int s2 = 0; s2 < 8; ++s2) { const float sv = segtot[s2 * 64 + d]; tot += sv; if (s2 < w) off += sv; }
        unsigned kh[8];
#pragma unroll
        for (int e = 0; e < 8; ++e) { const float cm = cum[e] + off; const int i = w * 8 + e;
            Qt[i * GLA_PT + d] = (bf16_t)f2bf(qc[e] * 0.125f * __expf(cm)); Kt[i * GLA_PT + d] = (bf16_t)f2bf(kc[e] * __expf(-cm)); kh[e] = f2bf(kc[e] * __expf(tot - cm)); }
        { u32x4 kw; kw.x = kh[0] | (kh[1] << 16); kw.y = kh[2] | (kh[3] << 16); kw.z = kh[4] | (kh[5] << 16); kw.w = kh[6] | (kh[7] << 16);
          *(u32x4*)(Kht + d * GLA_PT + w * 8) = kw; }
        if (w == 0) el[d] = __expf(tot);
#pragma unroll
        for (int u2 = 0; u2 < 2; ++u2) { const int idx = tid + 512 * u2, j = idx >> 4, vg = idx & 15;
#pragma unroll
            for (int e = 0; e < 4; ++e) { Vt[(vg * 8 + 2 * e) * GLA_PT + j] = (bf16_t)(vc[u2][e] & 0xffffu); Vt[(vg * 8 + 2 * e + 1) * GLA_PT + j] = (bf16_t)(vc[u2][e] >> 16); } }
#pragma unroll
        for (int dt = 0; dt < 4; ++dt)
#pragma unroll
            for (int jj = 0; jj < 4; ++jj) St[(w * 16 + fq * 4 + jj) * GLA_PT + dt * 16 + fr] = (bf16_t)f2bf(Sacc[dt][jj]);
        __syncthreads();
        { const int m = w >> 1;
#pragma unroll
          for (int nn = 0; nn < 2; ++nn) { const int n = (w & 1) * 2 + nn; f32x4 acc = {0.f, 0.f, 0.f, 0.f};
#pragma unroll
              for (int ks = 0; ks < 2; ++ks) { const bf16x8 a = *(const bf16x8*)(Qt + (m * 16 + fr) * GLA_PT + ks * 32 + fq * 8), b = *(const bf16x8*)(Kt + (n * 16 + fr) * GLA_PT + ks * 32 + fq * 8);
                  acc = __builtin_amdgcn_mfma_f32_16x16x32_bf16(a, b, acc, 0, 0, 0); }
#pragma unroll
              for (int jj = 0; jj < 4; ++jj) { const int i = m * 16 + fq * 4 + jj, j = n * 16 + fr; As[i * GLA_PT + j] = (j <= i) ? (bf16_t)f2bf(acc[jj]) : (bf16_t)0; } } }
        __syncthreads();
        bf16x8 bV[2], bS[2];
#pragma unroll
        for (int ks = 0; ks < 2; ++ks) { bV[ks] = *(const bf16x8*)(Vt + (w * 16 + fr) * GLA_PT + ks * 32 + fq * 8); bS[ks] = *(const bf16x8*)(St + (w * 16 + fr) * GLA_PT + ks * 32 + fq * 8); }
        const bool wr_out = !(skip_ctx_out && c < 4);
#pragma unroll
        for (int m = 0; m < 4; ++m) { f32x4 acc = {0.f, 0.f, 0.f, 0.f};
#pragma unroll
            for (int ks = 0; ks < 2; ++ks) { const bf16x8 aA = *(const bf16x8*)(As + (m * 16 + fr) * GLA_PT + ks * 32 + fq * 8), aQ = *(const bf16x8*)(Qt + (m * 16 + fr) * GLA_PT + ks * 32 + fq * 8);
                acc = __builtin_amdgcn_mfma_f32_16x16x32_bf16(aA, bV[ks], acc, 0, 0, 0); acc = __builtin_amdgcn_mfma_f32_16x16x32_bf16(aQ, bS[ks], acc, 0, 0, 0); }
            if (wr_out) {
#pragma unroll
                for (int jj = 0; jj < 4; ++jj) { const size_t row = (size_t)GLA_ROW(base, m * 16 + fq * 4 + jj); Op[row * 512 + h * 128 + w * 16 + fr] = acc[jj]; } } }
#pragma unroll
        for (int dt = 0; dt < 4; ++dt) { const float e = el[dt * 16 + fr]; Sacc[dt] = Sacc[dt] * e;
#pragma unroll
            for (int ks = 0; ks < 2; ++ks) { const bf16x8 bK = *(const bf16x8*)(Kht + (dt * 16 + fr) * GLA_PT + ks * 32 + fq * 8);
                Sacc[dt] = __builtin_amdgcn_mfma_f32_16x16x32_bf16(bV[ks], bK, Sacc[dt], 0, 0, 0); } }
        __syncthreads();
    }
#undef GLA_CHUNK
#undef GLA_ROW
#undef GLA_LOAD
}
__device__ __forceinline__ void gla_finish(const Params& p, int l, bool skip_ctx) {
    const int tid_ = otid(), lane = tid_ & 63, w = tid_ >> 6, tg = p.tg, c8 = lane * 8;
    const float* O0 = (const float*)(p.ws + WS_P); const float* O1 = O0 + (size_t)tg * 512; bf16_t* Zc = subbuf(p, C_ZC);
    const f32x4 n0 = *(const f32x4*)(p.c_norm + l * 512 + c8), n1 = *(const f32x4*)(p.c_norm + l * 512 + c8 + 4);
    for (int row = blockIdx.x * 8 + w; row < tg; row += gridDim.x * 8) {
        if (skip_ctx && (row % TPB) < CTX) continue;
        const size_t o = (size_t)row * 512 + c8;
        const f32x4 a = *(const f32x4*)(O0 + o) + *(const f32x4*)(O1 + o), b = *(const f32x4*)(O0 + o + 4) + *(const f32x4*)(O1 + o + 4);
        float ss = (a[0] * a[0] + a[1] * a[1]) + (a[2] * a[2] + a[3] * a[3]) + (b[0] * b[0] + b[1] * b[1]) + (b[2] * b[2] + b[3] * b[3]);
        ss += __shfl_xor(ss, 1); ss += __shfl_xor(ss, 2); ss += __shfl_xor(ss, 4); ss += __shfl_xor(ss, 8);
        const float rinv = rsqrtf(ss * (1.f / 128.f) + EPS);
        const u32x4 zw = *(const u32x4*)(Zc + o); u32x4 ow;
        ow.x = pk2(a[0] * rinv * n0[0] * silu(bf2f(zw.x & 0xffffu)), a[1] * rinv * n0[1] * silu(bf2f(zw.x >> 16)));
        ow.y = pk2(a[2] * rinv * n0[2] * silu(bf2f(zw.y & 0xffffu)), a[3] * rinv * n0[3] * silu(bf2f(zw.y >> 16)));
        ow.z = pk2(b[0] * rinv * n1[0] * silu(bf2f(zw.z & 0xffffu)), b[1] * rinv * n1[1] * silu(bf2f(zw.z >> 16)));
        ow.w = pk2(b[2] * rinv * n1[2] * silu(bf2f(zw.w & 0xffffu)), b[3] * rinv * n1[3] * silu(bf2f(zw.w >> 16)));
        *(u32x4*)(Zc + o) = ow;
    }
}
__global__ void __launch_bounds__(512, 2) hybrid_block_fwd(Params p) {
    extern __shared__ __attribute__((aligned(16))) unsigned char lds[];
    cg::grid_group grid = cg::this_grid();
    const int tg = p.tg, G = gridDim.x, bid = blockIdx.x, nb = tg / TPB, tpg = tg / 256;
#if PH & 1
    phase0(p, lds);
#endif
    grid.sync();
#if PH & 2
    ln_phase(p, 0, 0, 0, 0, NTOK, nullptr);
#endif
    grid.sync();
#pragma unroll 1
    for (int l = 0; l < 2; ++l) {
#pragma unroll 1
        for (int g = 0; g < p.ng; ++g) {
            const bool last = (l == 1);
            {
                pg8::Gemm gm{(const bf16_t*)(p.ws + WS_U) + (size_t)g * tg * 1024, (const bf16_t*)(p.ws + WS_WIN) + (size_t)l * NCOL * 1024, tg, NCOL, 1024};
                pg8::StaticOrder S; S.init(tg, NCOL, G, bid);
                pg8::EpiP E{p.ws + WS_P, tg};
#if PH & 4
                pg8::gemm_phase<pg8::EpiP, pg8::StaticOrder, true, true>((PG8_LAS unsigned char*)lds, gm, S, E);
#endif
            }
            grid.sync();
#if PH & 8
            r_items(p, l, g);
            qk_prep(p, l);
            short_conv(p, l);
            __syncthreads();
#endif
#if PH & 16
            conformer(p, l, lds);
#endif
            grid.sync();
            {
                const int n_gla = nb * 4 * 2, n_att_lat = nb * 32, n_att = n_att_lat + (last ? 0 : nb * 4);
                const bf16_t* Aq = subbuf(p, C_AQ); const bf16_t* Ak = subbuf(p, C_AK); const bf16_t* Av = subbuf(p, C_AV); bf16_t* Za = subbuf(p, C_ZA);
                for (int it = bid; it < n_gla + n_att; it += G) {
                    __syncthreads();
#if PH & 32
                    if (it < n_gla) { gla_chain(p, l, g, it >> 3, (it >> 1) & 3, it & 1, last, lds); continue; }
#endif
                    const int a = it - n_gla; int bl, h, qrow0, seq;
                    if (a < n_att_lat) { bl = a >> 5; h = (a >> 3) & 3; qrow0 = bl * TPB + CTX + (a & 7) * 256; seq = TPB; }
                    else { const int a2 = a - n_att_lat; bl = a2 >> 2; h = a2 & 3; qrow0 = bl * TPB; seq = CTX; }
                    const size_t kvo = (size_t)(bl * TPB) * 256 + (h >> 1) * 128;
#if PH & 64
                    att::attn_dense_body((const att::bf16*)(Aq + (size_t)qrow0 * 512 + h * 128), (const att::bf16*)(Ak + kvo), (const att::bf16*)(Av + kvo),
                                         Za + (size_t)qrow0 * 512 + h * 128, seq, (char*)lds);
#endif
                }
            }
            grid.sync();
#if PH & 128
            gla_finish(p, l, last);
#endif
            grid.sync();
            {
                pg8::Gemm gm{subbuf(p, C_ZA), (const bf16_t*)(p.ws + WS_WBR) + (size_t)l * 4 * 1024 * 512, tg, 1024, 512};
                pg8::BrOrder S{tpg * 4, G, bid, tpg};
                pg8::EpiBr E{subbuf(p, C_MG), (float*)(p.ws + WS_P), subbuf(p, C_AQ), tpg};
#if PH & 256
                pg8::gemm_phase<pg8::EpiBr, pg8::BrOrder, true, true>((PG8_LAS unsigned char*)lds, gm, S, E);
#endif
            }
            grid.sync();
            float* hpre = (float*)subbuf(p, C_MG);
            {
                pg8::Gemm gm{subbuf(p, C_AQ), (const bf16_t*)(p.ws + WS_WOUT) + (size_t)l * 1024 * 1024, tg, 1024, 1024};
                pg8::StaticOrder S; S.init(tg, 1024, G, bid);
                pg8::EpiOut E{p, hpre, l, g};
#if PH & 512
                pg8::gemm_phase<pg8::EpiOut, pg8::StaticOrder, true, true>((PG8_LAS unsigned char*)lds, gm, S, E);
#endif
            }
            grid.sync();
#if PH & 1024
            ln_phase(p, last ? 2 : 1, l, last ? 1 : l + 1, g * tg, tg, hpre);
#endif
            grid.sync();
        }
    }
}

extern "C" void kernel_launch(void* const* d_in, const int* in_sizes, int n_in, void* d_out, int out_size, void* d_ws, size_t ws_size, hipStream_t stream) {
    static int grid_blocks = 0;
    if (grid_blocks == 0) {
        int dev = 0, cus = 0, per_cu = 0;
        hipGetDevice(&dev);
        hipDeviceGetAttribute(&cus, hipDeviceAttributeMultiprocessorCount, dev);
        hipFuncSetAttribute((const void*)hybrid_block_fwd, hipFuncAttributeMaxDynamicSharedMemorySize, LDS_BYTES);
        hipOccupancyMaxActiveBlocksPerMultiprocessor(&per_cu, (const void*)hybrid_block_fwd, 512, LDS_BYTES);
        if (per_cu < 1) { fprintf(stderr, "kernel_launch: occupancy query reports %d blocks per CU\n", per_cu); per_cu = 1; }
        if (per_cu > 1) per_cu = 1;
        grid_blocks = cus * per_cu;
    }
    Params p{};
    const float** f = (const float**)&p;
    for (int i = 0; i < 21; ++i) f[i] = (const float*)d_in[i];
    p.out = (float*)d_out; p.ws = (unsigned char*)d_ws;
    p.ng = (ws_size >= WS_P + (size_t)9216 * NCOL * 2) ? 2 : 4;
    p.tg = NTOK / p.ng;
    void* args[] = {&p};
    hipError_t e = hipLaunchCooperativeKernel((const void*)hybrid_block_fwd, dim3(grid_blocks), dim3(512), args, LDS_BYTES, stream);
    if (e != hipSuccess) fprintf(stderr, "cooperative launch failed: %s (grid %d)\n", hipGetErrorString(e), grid_blocks);
}
```

```cpp
#include <hip/hip_runtime.h>
#include <hip/hip_bf16.h>
#include <hip/hip_cooperative_groups.h>
#include <cstdio>
#include <cstdint>
namespace cg = cooperative_groups;
#ifndef PH
#define PH 2047
#endif
#ifndef PROBE_A
#define PROBE_A -1
#endif
#ifndef PROBE_B
#define PROBE_B -1
#endif
#define PROBING (PROBE_A >= 0 || PROBE_B >= 0)
#ifndef REP
#define REP 0
#endif
#if REP & 4
#define GSYNC() do { xcd_barrier(xbar); xcd_barrier(xbar); } while (0)
#else
#define GSYNC() xcd_barrier(xbar)
#endif

constexpr int DM = 1024, NBATCH = 8, SEQ = 2048, CTX = 256, TPB = CTX + SEQ, NTOK = NBATCH * TPB;
constexpr int NCOL = 10752, WIN_COLS = 10784;
constexpr float EPS = 1e-6f, ALPHA = 1.41421356237f;
constexpr int C_BG = 0, C_CG = 512, C_XIN = 1024, C_GLU = 1536, C_AQ = 2560, C_AK = 3072, C_AV = 3328, C_CQ = 3584, C_CK = 3840, C_CV = 4096,
              C_ZA = 4608, C_ZB = 5120, C_ZC = 5632, C_ZD = 6144, C_MG = 6656;
constexpr size_t WS_WIN = 0;
constexpr size_t WS_WR = WS_WIN + (size_t)2 * NCOL * 1024 * 2;
constexpr size_t WS_WBR = WS_WR + (size_t)2 * 32 * 1024 * 2;
constexpr size_t WS_WOUT = WS_WBR + (size_t)2 * 4 * 1024 * 512 * 2;
constexpr size_t WS_MOD = WS_WOUT + (size_t)2 * 1024 * 1024 * 2;
constexpr size_t WS_U = WS_MOD + (size_t)2 * 9 * 3072 * 4;
constexpr size_t WS_R = WS_U + (size_t)NTOK * 1024 * 2;
constexpr size_t WS_HCTX = WS_R + (size_t)NTOK * 32 * 4;
constexpr size_t WS_BAR = WS_HCTX + (size_t)NBATCH * CTX * 1024 * 4;
constexpr size_t WS_P = WS_BAR + 16384;
constexpr int LDS_BYTES = 131072 + 1024;

typedef unsigned short bf16_t;
typedef short bf16x8 __attribute__((ext_vector_type(8)));
typedef float f32x4 __attribute__((ext_vector_type(4)));
typedef unsigned u32x4 __attribute__((ext_vector_type(4)));

struct Params {
    const float *x, *c, *ctx, *c_ctx, *w_mod, *b_mod, *w_in, *q_norm, *k_norm, *b_conv, *c_gate_w2, *c_gate_b, *c_norm,
                *d_conv_w, *d_conv_b, *d_norm_g, *d_norm_b, *w_br, *w_out, *ln_g, *ln_b;
    float* out; unsigned char* ws;
    int ng, tg;
};

__device__ __forceinline__ int otid() { int t = threadIdx.x; asm volatile("" : "+v"(t)); return t; }
__device__ __forceinline__ float bf2f(unsigned v) { return __uint_as_float(v << 16); }
__device__ __forceinline__ unsigned f2bf(float f) { unsigned u = __float_as_uint(f); return (u + 0x7fffu + ((u >> 16) & 1u)) >> 16; }
__device__ __forceinline__ unsigned pk2(float lo, float hi) { return f2bf(lo) | (f2bf(hi) << 16); }
__device__ __forceinline__ float sigm(float x) { return 1.f / (1.f + __expf(-x)); }
__device__ __forceinline__ float silu(float x) { return x / (1.f + __expf(-x)); }
__device__ __forceinline__ float wave_sum(float v) {
#pragma unroll
    for (int o = 32; o > 0; o >>= 1) v += __shfl_xor(v, o);
    return v;
}
__device__ __forceinline__ bf16_t* subbuf(const Params& p, int col) { return (bf16_t*)(p.ws + WS_P + (size_t)col * p.tg * 2); }
struct SubInfo { int col0, width, orig0; };
__device__ __forceinline__ SubInfo sub_info(int col) {
    if (col < 512) return {0, 512, 1536};
    if (col < 1024) return {512, 512, 2048};
    if (col < 1536) return {1024, 512, 2560};
    if (col < 2560) return {1536, 1024, 5152};
    if (col < 3072) return {2560, 512, 0};
    if (col < 3328) return {3072, 256, 512};
    if (col < 3584) return {3328, 256, 768};
    if (col < 3840) return {3584, 256, 3584};
    if (col < 4096) return {3840, 256, 3840};
    if (col < 4608) return {4096, 512, 4096};
    if (col < 5120) return {4608, 512, 1024};
    if (col < 5632) return {5120, 512, 3072};
    if (col < 6144) return {5632, 512, 4608};
    if (col < 6656) return {6144, 512, 6176};
    return {6656, 4096, 6688};
}
__device__ __forceinline__ const float* h_in_row(const Params& p, int l, int grow) {
    const int b = grow / TPB, s = grow % TPB;
    if (l == 0) return s < CTX ? p.ctx + ((size_t)b * CTX + s) * 1024 : p.x + ((size_t)b * SEQ + (s - CTX)) * 1024;
    return s < CTX ? (const float*)(p.ws + WS_HCTX) + ((size_t)b * CTX + s) * 1024 : p.out + ((size_t)b * SEQ + (s - CTX)) * 1024;
}
namespace att {
using bf16 = __hip_bfloat16;
constexpr int D = 128, NW = 8, QBLK = 32, KVBLK = 64;
constexpr float SCALE = 0.088388347648318440f;
constexpr float THR = 8.f;
constexpr int SDEPTH = 2;
constexpr int LDQ = 512, LDK = 256, LDZ = 512;
constexpr size_t SHM_V = KVBLK * D * 2, SHM_K = KVBLK * D * 2, SHM_ATTN = 2 * SHM_V + 2 * SHM_K + NW * 64 * 4;
using bf16x8 = __attribute__((ext_vector_type(8))) short;
using s16x4  = __attribute__((ext_vector_type(4))) short;
using f32x16 = __attribute__((ext_vector_type(16))) float;
using f32x8  = __attribute__((ext_vector_type(8))) float;
using u32x4  = __attribute__((ext_vector_type(4))) unsigned;
#define KSWZ(row, colB) ((row) * 256 + ((colB) ^ (((row) & 7) << 4)))
#define SBAR() __builtin_amdgcn_sched_barrier(0)
__device__ __forceinline__ int crow(int r, int hi) { return (r & 3) + 8 * (r >> 2) + 4 * hi; }
__device__ __forceinline__ unsigned cvtpk(float lo, float hi) {
  unsigned r; asm volatile("v_cvt_pk_bf16_f32 %0, %1, %2" : "=v"(r) : "v"(lo), "v"(hi)); return r;
}
template <typename TIn> struct Stage;
template <> struct Stage<bf16>  { using T = bf16x8;
  __device__ static __forceinline__ T ld8(const bf16* p) { return *reinterpret_cast<const bf16x8*>(p); }
  __device__ static __forceinline__ bf16x8 tobf(T x) { return x; } };
__device__ __forceinline__ void partialSM(f32x16& p0, f32x16& p1, float& m_reg, float& mn, float& alpha) {
  constexpr float C = SCALE * 1.4426950408889634f;
  float pmax = p0[0]; for (int r = 1; r < 16; ++r) pmax = fmaxf(pmax, p0[r]); for (int r = 0; r < 16; ++r) pmax = fmaxf(pmax, p1[r]);
  { auto rr = __builtin_amdgcn_permlane32_swap(__float_as_uint(pmax), __float_as_uint(pmax), false, false);
    pmax = fmaxf(__uint_as_float(rr[0]), __uint_as_float(rr[1])); }
  if (__builtin_expect(__all(pmax - m_reg <= THR / SCALE), 1)) { mn = m_reg; alpha = 1.f; }
  else { mn = fmaxf(m_reg, pmax); alpha = __builtin_amdgcn_exp2f((m_reg - mn) * C); m_reg = mn; }
  float mnC = -mn * C;
  for (int r = 0; r < 16; ++r) p0[r] = fmaf(p0[r], C, mnC); for (int r = 0; r < 16; ++r) p1[r] = fmaf(p1[r], C, mnC);
  for (int r = 0; r < 16; ++r) p0[r] = __builtin_amdgcn_exp2f(p0[r]);
}
__device__ __forceinline__ void finishSM(f32x16& p0, f32x16& p1, float alpha, float& l_reg, bf16x8& pa0, bf16x8& pa1, bf16x8& pa2, bf16x8& pa3) {
  for (int r = 0; r < 16; ++r) p1[r] = __builtin_amdgcn_exp2f(p1[r]);
  float ps = 0; for (int r = 0; r < 16; ++r) ps += p0[r]; for (int r = 0; r < 16; ++r) ps += p1[r];
  { auto rr = __builtin_amdgcn_permlane32_swap(__float_as_uint(ps), __float_as_uint(ps), false, false);
    ps = __uint_as_float(rr[0]) + __uint_as_float(rr[1]); }
  l_reg = l_reg * alpha + ps;
#define PK4(P, BASE, OUT) do { unsigned a0 = cvtpk(P[BASE + 0], P[BASE + 1]), a1 = cvtpk(P[BASE + 2], P[BASE + 3]);   \
    unsigned b0 = cvtpk(P[BASE + 4], P[BASE + 5]), b1 = cvtpk(P[BASE + 6], P[BASE + 7]);                              \
    auto r0 = __builtin_amdgcn_permlane32_swap(a0, b0, false, false); auto r1 = __builtin_amdgcn_permlane32_swap(a1, b1, false, false); \
    u32x4 w = {r0[0], r1[0], r0[1], r1[1]}; OUT = *reinterpret_cast<bf16x8*>(&w); } while (0)
  PK4(p0, 0, pa0); PK4(p0, 8, pa1); PK4(p1, 0, pa2); PK4(p1, 8, pa3);
#undef PK4
}
__device__ __forceinline__ void qkt(f32x16& p0, f32x16& p1, const bf16* Ks, const bf16x8* qr, int r32, int hi) {
  p0 = f32x16{}; p1 = f32x16{};
  for (int d0 = 0; d0 < 8; ++d0) { int cb = (d0 * 16 + hi * 8) * 2;
    bf16x8 b0 = *reinterpret_cast<const bf16x8*>((const char*)Ks + KSWZ(r32, cb));
    bf16x8 b1 = *reinterpret_cast<const bf16x8*>((const char*)Ks + KSWZ(32 + r32, cb));
    p0 = __builtin_amdgcn_mfma_f32_32x32x16_bf16(b0, qr[d0], p0, 0, 0, 0);
    p1 = __builtin_amdgcn_mfma_f32_32x32x16_bf16(b1, qr[d0], p1, 0, 0, 0); }
}
__device__ __forceinline__ int v_st(int k, int c) { const int kk = (k & ~0xC) | ((k & 4) << 1) | ((k & 8) >> 1); return ((kk >> 3) * 4 + (c >> 5)) * 512 + ((kk & 7) * 32 + (c & 31)) * 2; }
__device__ __forceinline__ int v_rd_base(int lane) { return ((lane & 3) << 3) | (((lane >> 2) & 3) << 6) | (((lane >> 4) & 1) << 5) | (((lane >> 5) & 1) << 8); }
constexpr int v_rd_off(int d0, int ks, int half) { return d0 * 512 + ks * 4096 + half * 2048; }
template <int OFF> __device__ __forceinline__ s16x4 tr_read(int vb) {
  s16x4 r; asm volatile("ds_read_b64_tr_b16 %0, %1 offset:%2" : "=&v"(r) : "v"(vb), "i"(OFF) : "memory"); return r;
}
template <int D0> __device__ __forceinline__ void pv_one(f32x16& od, int vb, bf16x8 pa0, bf16x8 pa1, bf16x8 pa2, bf16x8 pa3) {
  const s16x4 l0 = tr_read<v_rd_off(D0, 0, 0)>(vb), h0 = tr_read<v_rd_off(D0, 0, 1)>(vb), l1 = tr_read<v_rd_off(D0, 1, 0)>(vb), h1 = tr_read<v_rd_off(D0, 1, 1)>(vb);
  const s16x4 l2 = tr_read<v_rd_off(D0, 2, 0)>(vb), h2 = tr_read<v_rd_off(D0, 2, 1)>(vb), l3 = tr_read<v_rd_off(D0, 3, 0)>(vb), h3 = tr_read<v_rd_off(D0, 3, 1)>(vb);
  asm volatile("s_waitcnt lgkmcnt(0)" ::: "memory"); SBAR();
#define PK(L, H) (bf16x8){L[0], L[1], L[2], L[3], H[0], H[1], H[2], H[3]}
  od = __builtin_amdgcn_mfma_f32_32x32x16_bf16(pa0, PK(l0, h0), od, 0, 0, 0);
  od = __builtin_amdgcn_mfma_f32_32x32x16_bf16(pa1, PK(l1, h1), od, 0, 0, 0);
  od = __builtin_amdgcn_mfma_f32_32x32x16_bf16(pa2, PK(l2, h2), od, 0, 0, 0);
  od = __builtin_amdgcn_mfma_f32_32x32x16_bf16(pa3, PK(l3, h3), od, 0, 0, 0);
#undef PK
}
__device__ __forceinline__ void pv_d0(f32x16* o, int vb, bf16x8 pa0, bf16x8 pa1, bf16x8 pa2, bf16x8 pa3) {
  pv_one<0>(o[0], vb, pa0, pa1, pa2, pa3); pv_one<1>(o[1], vb, pa0, pa1, pa2, pa3); pv_one<2>(o[2], vb, pa0, pa1, pa2, pa3); pv_one<3>(o[3], vb, pa0, pa1, pa2, pa3);
}

__device__ __forceinline__ void attn_dense_body(const bf16* __restrict__ Qb, const bf16* __restrict__ Kh, const bf16* __restrict__ Vh,
                                                unsigned short* __restrict__ Zb, int seq, char* lds, bool dry = false) {
  using TQ = bf16;
  using St = Stage<bf16>; using SQ = Stage<TQ>;
  const int tid = otid(), wid = tid >> 6, lane = tid & 63, r32 = lane & 31, hi = lane >> 5;
  bf16* V_lds = (bf16*)lds; bf16* K_lds = (bf16*)(lds + 2 * SHM_V);
  float* ws = (float*)(lds + 2 * SHM_V + 2 * SHM_K) + wid * 64; float* li_l = ws; float* al_l = ws + 32;
  float m_reg = -1e30f, l_reg = 0; f32x16 o[4] = {}; bf16x8 qr[8];
  const TQ* Qw = Qb + (long)(wid * QBLK + r32) * LDQ + hi * 8;
#pragma unroll
  for (int d0 = 0; d0 < 8; ++d0) qr[d0] = SQ::tobf(SQ::ld8(Qw + d0 * 16));
  const int sr = tid >> 4, sc = (tid & 15) * 8, vst0 = v_st(sr, sc), vst1 = v_st(32 + sr, sc);
  const int vb0 = (int)(uintptr_t)V_lds + v_rd_base(lane);
  struct { typename St::T vs0, vs1, ks0, ks1; } sr_[SDEPTH];
#define SLOAD(i, k0) do { sr_[i].vs0 = St::ld8(&Vh[(long)((k0) + sr) * LDK + sc]); sr_[i].vs1 = St::ld8(&Vh[(long)((k0) + 32 + sr) * LDK + sc]); \
    sr_[i].ks0 = St::ld8(&Kh[(long)((k0) + sr) * LDK + sc]); sr_[i].ks1 = St::ld8(&Kh[(long)((k0) + 32 + sr) * LDK + sc]); } while (0)
#define SWRITE(b, i) do { *(bf16x8*)((char*)V_lds + (b) * SHM_V + vst0) = St::tobf(sr_[i].vs0);          \
    *(bf16x8*)((char*)V_lds + (b) * SHM_V + vst1) = St::tobf(sr_[i].vs1); int kc = sc * 2;               \
    *(bf16x8*)((char*)K_lds + (b) * SHM_K + KSWZ(sr, kc)) = St::tobf(sr_[i].ks0);                       \
    *(bf16x8*)((char*)K_lds + (b) * SHM_K + KSWZ(32 + sr, kc)) = St::tobf(sr_[i].ks1); } while (0)
#define SWAIT() do { if constexpr (SDEPTH == 2) asm volatile("s_waitcnt vmcnt(4)" ::: "memory"); else asm volatile("s_waitcnt vmcnt(0)" ::: "memory"); } while (0)
#define RESC(a) do { if (__any((a) < 1.f)) { if (hi == 0) al_l[r32] = (a); asm volatile("s_waitcnt lgkmcnt(0)" ::: "memory"); \
    for (int d = 0; d < 4; ++d) for (int r = 0; r < 16; ++r) o[d][r] *= al_l[crow(r, hi)]; } } while (0)
  f32x16 pA0, pA1, pB0, pB1; float mnA, mnB, alA, alB; bf16x8 pa0, pa1, pa2, pa3; const int NT = seq / KVBLK;
  constexpr int SE = 0, SO = SDEPTH - 1;
  SLOAD(SE, 0); asm volatile("s_waitcnt vmcnt(0)" ::: "memory"); SWRITE(0, SE); __syncthreads();
  qkt(pA0, pA1, K_lds, qr, r32, hi); partialSM(pA0, pA1, m_reg, mnA, alA);
  SLOAD(SO, KVBLK); if constexpr (SDEPTH == 2) { if (2 < NT) SLOAD(SE, 2 * KVBLK); }
  SWAIT(); SWRITE(1, SO); __syncthreads();
  for (int j = 1; j + 1 < NT; j += 2) {
    SBAR(); qkt(pB0, pB1, (bf16*)((char*)K_lds + SHM_K), qr, r32, hi);
    finishSM(pA0, pA1, alA, l_reg, pa0, pa1, pa2, pa3); SBAR();
    SLOAD(SO, (j + SDEPTH) * KVBLK); SBAR();
    pv_d0(o, vb0, pa0, pa1, pa2, pa3); partialSM(pB0, pB1, m_reg, mnB, alB);
    __syncthreads(); SWAIT(); SWRITE(0, SE);
    RESC(alB); __syncthreads();
    SBAR(); qkt(pA0, pA1, K_lds, qr, r32, hi);
    finishSM(pB0, pB1, alB, l_reg, pa0, pa1, pa2, pa3); SBAR();
    if (SDEPTH == 1 || j + 3 < NT) SLOAD(SE, (j + 1 + SDEPTH) * KVBLK); SBAR();
    pv_d0(o, vb0 + (int)SHM_V, pa0, pa1, pa2, pa3); partialSM(pA0, pA1, m_reg, mnA, alA);
    __syncthreads(); SWAIT(); SWRITE(1, SO);
    RESC(alA); __syncthreads();
  }
  SBAR(); qkt(pB0, pB1, (bf16*)((char*)K_lds + SHM_K), qr, r32, hi);
  finishSM(pA0, pA1, alA, l_reg, pa0, pa1, pa2, pa3); SBAR();
  pv_d0(o, vb0, pa0, pa1, pa2, pa3); partialSM(pB0, pB1, m_reg, mnB, alB);
  __syncthreads(); RESC(alB);
  finishSM(pB0, pB1, alB, l_reg, pa0, pa1, pa2, pa3); SBAR();
  pv_d0(o, vb0 + (int)SHM_V, pa0, pa1, pa2, pa3);
  if (hi == 0) li_l[r32] = l_reg; asm volatile("s_waitcnt lgkmcnt(0)" ::: "memory");
  float rli[16];
#pragma unroll
  for (int r = 0; r < 16; ++r) rli[r] = __builtin_amdgcn_rcpf(li_l[crow(r, hi)]);
  unsigned short* Zw = Zb + (long)(wid * QBLK) * LDZ;
#pragma unroll
  for (int r = 0; r < 16; ++r) { int orow = crow(r, hi);
#pragma unroll
    for (int d0 = 0; d0 < 4; ++d0) { unsigned short* zp = Zw + (long)orow * LDZ + d0 * 32 + r32;
      const float z = __uint_as_float(((unsigned)*zp) << 16); const float val = o[d0][r] * rli[r] * (z / (1.f + __expf(-z)));
      unsigned u = __float_as_uint(val); if (!dry) *zp = (unsigned short)((u + 0x7fffu + ((u >> 16) & 1u)) >> 16); } }
#undef SLOAD
#undef SWRITE
#undef SWAIT
#undef RESC
}
#undef KSWZ
#undef SBAR
}
namespace pg8 {
#define PG8_LAS __attribute__((address_space(3)))
typedef unsigned short bf16_t;
typedef short bf16x8 __attribute__((ext_vector_type(8)));
typedef float f32x4 __attribute__((ext_vector_type(4)));
typedef unsigned u32x4 __attribute__((ext_vector_type(4)));
constexpr int BM = 256, BK = 64, HALF = 128, HTB = HALF * BK * 2  , STAGE_BYTES = 8 * HTB, NXCD = 8, WGM = 4;

__host__ __device__ __forceinline__ int lds_byte(int r, int c) { const int st = (r >> 4) * 2 + (c >> 5), rr = r & 15, cc = c & 31, ob = rr * 64 + cc * 2; return st * 1024 + (ob ^ (((ob >> 9) & 1) << 5)); }
__host__ __device__ __forceinline__ void stage_rc(int b, int& R, int& C) { const int st = b / 1024, sb = b % 1024, swz = sb ^ (((sb >> 9) & 1) << 5); R = (st >> 1) * 16 + swz / 64; C = (st & 1) * 32 + (swz % 64) / 2; }
__host__ __device__ __forceinline__ int perm32(int rho) { const int n = rho >> 4, i = rho & 15; return 8 * (i >> 2) + 4 * n + (i & 3); }

struct Unit { int pm, pn; };
struct Gemm { const bf16_t* A; const bf16_t* Bt; int M, N, K; };

struct StaticOrder {
    int nM, nN, nwg, G, c;
    __host__ __device__ void init(int M, int N, int G_, int c_) { nM = M / BM; nN = N / BM; nwg = nM * nN; G = G_; c = c_; }
    __host__ __device__ bool next(int i, Unit& u) const {
        const long L = (long)i * G + c; if (L >= nwg) return false;
        int wgid = (int)L; { const int q = nwg / NXCD, r = nwg % NXCD, xcd = wgid % NXCD, off = wgid / NXCD; wgid = (xcd < r ? xcd * (q + 1) : r * (q + 1) + (xcd - r) * q) + off; }
        const int nig = WGM * nN, gid = wgid / nig, fm = gid * WGM, gsz = (nM - fm) < WGM ? (nM - fm) : WGM;
        u.pm = fm + ((wgid % nig) % gsz); u.pn = (wgid % nig) / gsz; return true;
    }
    __device__ __forceinline__ void a_ready(const Unit&) const {}
    __device__ __forceinline__ void done(const Unit&) const {}
};

__device__ __forceinline__ unsigned cvt_pk_bf16(float lo, float hi) { unsigned r; asm volatile("v_cvt_pk_bf16_f32 %0, %1, %2" : "=v"(r) : "v"(lo), "v"(hi)); return r; }
struct EpiP {
    static constexpr bool PERM = true, AFTER_DRAIN = false;
    unsigned char* P; int tg;
    __device__ __forceinline__ void operator()(const f32x4 (&acc)[2][2][4][2], const Unit& u, int wr, int wc, int fr, int fq) const {
        const SubInfo si = sub_info(u.pn * BM);
        bf16_t* base = (bf16_t*)(P + (size_t)si.col0 * tg * 2);
        const int lc = u.pn * BM - si.col0 + wc * 32 + 8 * fq, row0 = u.pm * BM + wr * 64 + fr;
        if (si.col0 == C_GLU) {
            const int vc = ((u.pn * BM - C_GLU) >> 8) * 128 + wc * 32 + 8 * fq;
#pragma unroll
            for (int ai = 0; ai < 2; ++ai)
#pragma unroll
                for (int m = 0; m < 4; ++m) { const f32x4 a0 = acc[ai][0][m][0], a1 = acc[ai][0][m][1], g0 = acc[ai][1][m][0], g1 = acc[ai][1][m][1];
                    u32x4 w; w.x = cvt_pk_bf16(a0[0] * sigm(g0[0]), a0[1] * sigm(g0[1])); w.y = cvt_pk_bf16(a0[2] * sigm(g0[2]), a0[3] * sigm(g0[3]));
                    w.z = cvt_pk_bf16(a1[0] * sigm(g1[0]), a1[1] * sigm(g1[1])); w.w = cvt_pk_bf16(a1[2] * sigm(g1[2]), a1[3] * sigm(g1[3]));
                    *(u32x4*)(base + (size_t)(row0 + ai * HALF + m * 16) * 512 + vc) = w; }
            return;
        }
#pragma unroll
        for (int ai = 0; ai < 2; ++ai)
#pragma unroll
            for (int m = 0; m < 4; ++m) { bf16_t* rowp = base + (size_t)(row0 + ai * HALF + m * 16) * si.width + lc;
#pragma unroll
                for (int bj = 0; bj < 2; ++bj) { const f32x4 v0 = acc[ai][bj][m][0], v1 = acc[ai][bj][m][1];
                    u32x4 w; w.x = cvt_pk_bf16(v0[0], v0[1]); w.y = cvt_pk_bf16(v0[2], v0[3]); w.z = cvt_pk_bf16(v1[0], v1[1]); w.w = cvt_pk_bf16(v1[2], v1[3]);
                    *(u32x4*)(rowp + bj * HALF) = w; } }
    }
};
struct BrOrder {
    int ntile, G, c, tpg;
    __device__ __forceinline__ bool next(int i, Unit& u) const {
        const int tile = c + (i >> 2) * G; if (tile >= ntile) return false;
        const int br = i & 3; u.pm = br * tpg + (tile >> 2); u.pn = br * 4 + (tile & 3); return true;
    }
    __device__ __forceinline__ void a_ready(const Unit&) const {}
    __device__ __forceinline__ void done(const Unit&) const {}
};
struct EpiBr {
    static constexpr bool PERM = true, AFTER_DRAIN = false;
    const bf16_t* MG; float* Macc; bf16_t* merged; int tpg;
    __device__ __forceinline__ void operator()(const f32x4 (&acc)[2][2][4][2], const Unit& u, int wr, int wc, int fr, int fq) const {
        const int br = u.pn >> 2, pn = u.pn & 3, pm = u.pm - br * tpg;
        const int row0 = pm * BM + wr * 64 + fr, col0 = pn * BM + wc * 32 + 8 * fq;
#pragma unroll
        for (int ai = 0; ai < 2; ++ai)
#pragma unroll
            for (int m = 0; m < 4; ++m) { const size_t row = (size_t)(row0 + ai * HALF + m * 16);
#pragma unroll
                for (int bj = 0; bj < 2; ++bj) { const int col = col0 + bj * HALF;
                    const u32x4 gw = *(const u32x4*)(MG + row * 4096 + br * 1024 + col);
                    f32x4 v0 = acc[ai][bj][m][0], v1 = acc[ai][bj][m][1];
                    v0[0] *= sigm(bf2f(gw.x & 0xffffu)); v0[1] *= sigm(bf2f(gw.x >> 16)); v0[2] *= sigm(bf2f(gw.y & 0xffffu)); v0[3] *= sigm(bf2f(gw.y >> 16));
                    v1[0] *= sigm(bf2f(gw.z & 0xffffu)); v1[1] *= sigm(bf2f(gw.z >> 16)); v1[2] *= sigm(bf2f(gw.w & 0xffffu)); v1[3] *= sigm(bf2f(gw.w >> 16));
                    bf16_t* mp = (bf16_t*)Macc + row * 1024 + col;
                    if (br > 0) { const u32x4 pw = *(const u32x4*)mp;
                        v0[0] += bf2f(pw.x & 0xffffu); v0[1] += bf2f(pw.x >> 16); v0[2] += bf2f(pw.y & 0xffffu); v0[3] += bf2f(pw.y >> 16);
                        v1[0] += bf2f(pw.z & 0xffffu); v1[1] += bf2f(pw.z >> 16); v1[2] += bf2f(pw.w & 0xffffu); v1[3] += bf2f(pw.w >> 16); }
                    { u32x4 w; w.x = cvt_pk_bf16(v0[0], v0[1]); w.y = cvt_pk_bf16(v0[2], v0[3]); w.z = cvt_pk_bf16(v1[0], v1[1]); w.w = cvt_pk_bf16(v1[2], v1[3]);
                        if (br < 3) *(u32x4*)mp = w; else
                        *(u32x4*)(merged + row * 1024 + col) = w; } } }
    }
};
struct BrOrder2 {
    int ntile, G, c, tpg;
    __device__ __forceinline__ bool next(int i, Unit& u) const {
        const int L = i * G + c; if (L >= 4 * ntile) return false;
        const int br = L / ntile, t = L - br * ntile; u.pm = br * tpg + (t >> 2); u.pn = br * 4 + (t & 3); return true;
    }
    __device__ __forceinline__ void a_ready(const Unit&) const {}
    __device__ __forceinline__ void done(const Unit&) const {}
};
struct EpiBr2 {
    static constexpr bool PERM = true, AFTER_DRAIN = false;
    const bf16_t* MG; bf16_t* Gb; int tpg; size_t gstride;
    __device__ __forceinline__ void operator()(const f32x4 (&acc)[2][2][4][2], const Unit& u, int wr, int wc, int fr, int fq) const {
        const int br = u.pn >> 2, pn = u.pn & 3, pm = u.pm - br * tpg;
        const int row0 = pm * BM + wr * 64 + fr, col0 = pn * BM + wc * 32 + 8 * fq;
        bf16_t* Go = Gb + (size_t)br * gstride;
#pragma unroll
        for (int ai = 0; ai < 2; ++ai)
#pragma unroll
            for (int m = 0; m < 4; ++m) { const size_t row = (size_t)(row0 + ai * HALF + m * 16);
                u32x4 gw[2];
#pragma unroll
                for (int bj = 0; bj < 2; ++bj) gw[bj] = *(const u32x4*)(MG + row * 4096 + br * 1024 + col0 + bj * HALF);
#pragma unroll
                for (int bj = 0; bj < 2; ++bj) { const int col = col0 + bj * HALF;
                    f32x4 v0 = acc[ai][bj][m][0], v1 = acc[ai][bj][m][1];
                    v0[0] *= sigm(bf2f(gw[bj].x & 0xffffu)); v0[1] *= sigm(bf2f(gw[bj].x >> 16)); v0[2] *= sigm(bf2f(gw[bj].y & 0xffffu)); v0[3] *= sigm(bf2f(gw[bj].y >> 16));
                    v1[0] *= sigm(bf2f(gw[bj].z & 0xffffu)); v1[1] *= sigm(bf2f(gw[bj].z >> 16)); v1[2] *= sigm(bf2f(gw[bj].w & 0xffffu)); v1[3] *= sigm(bf2f(gw[bj].w >> 16));
                    u32x4 w; w.x = cvt_pk_bf16(v0[0], v0[1]); w.y = cvt_pk_bf16(v0[2], v0[3]); w.z = cvt_pk_bf16(v1[0], v1[1]); w.w = cvt_pk_bf16(v1[2], v1[3]);
                    *(u32x4*)(Go + row * 1024 + col) = w; } }
    }
};
struct EpiOut {
    static constexpr bool PERM = true, AFTER_DRAIN = false;
    Params p; float* hpre; int l, g;
    __device__ __forceinline__ void operator()(const f32x4 (&acc)[2][2][4][2], const Unit& u, int wr, int wc, int fr, int fq) const {
        const int row0 = u.pm * BM + wr * 64 + fr, col0 = u.pn * BM + wc * 32 + 8 * fq;
        const float* mod = (const float*)(p.ws + WS_MOD);
#pragma unroll
        for (int ai = 0; ai < 2; ++ai)
#pragma unroll
            for (int m = 0; m < 4; ++m) { const int row = row0 + ai * HALF + m * 16, grow = g * p.tg + row, b = grow / TPB, s = grow % TPB;
                const float* hr = h_in_row(p, l, grow); const float* gt = mod + ((size_t)l * 9 + (s < CTX ? 8 : b)) * 3072 + 2048;
#pragma unroll
                for (int bj = 0; bj < 2; ++bj) { const int col = col0 + bj * HALF;
                    const f32x4 h0 = *(const f32x4*)(hr + col), h1 = *(const f32x4*)(hr + col + 4), g0 = *(const f32x4*)(gt + col), g1 = *(const f32x4*)(gt + col + 4);
                    float* op = hpre + (size_t)row * 1024 + col;
                    *(f32x4*)op = h0 * ALPHA + g0 * acc[ai][bj][m][0]; *(f32x4*)(op + 4) = h1 * ALPHA + g1 * acc[ai][bj][m][1]; } }
    }
};
template <class Epi, class Sched, bool ALIGN_EPI = false, bool SP2 = false>
__device__ __forceinline__ void gemm_phase(PG8_LAS unsigned char* lds, const Gemm g, const Sched& S, const Epi& E) {
    const int tid = otid(), wid = __builtin_amdgcn_readfirstlane(tid >> 6), lane = tid & 63, wr = wid >> 2, wc = wid & 3, fr = lane & 15, fq = lane >> 4;
    const int K = g.K, nt = K / BK;
    unsigned voffA[2], voffB[2];
#pragma unroll
    for (int i = 0; i < 2; ++i) { int R, C; stage_rc(tid * 16 + i * 8192, R, C); const int Rb = Epi::PERM ? ((R & ~31) + perm32(R & 31)) : R;
        voffA[i] = (unsigned)(R * K + C) * 2u; voffB[i] = (unsigned)(Rb * K + C) * 2u; }
    const size_t kstep = (size_t)(BK * 2);
    const size_t hstep = (size_t)HALF * K * 2;
    const size_t tstep = 2 * hstep;
    const unsigned ldsw = (unsigned)wid * 1024u;
    const int aoff = lds_byte(wr * 64 + fr, fq * 8), boff = lds_byte(wc * 32 + fr, fq * 8);
#define PG8_SA(b, h) (((b) * 2 + (h)) * HTB)
#define PG8_SB(b, h) ((4 + (b) * 2 + (h)) * HTB)
#define PG8_STAGE(bufoff, gbase, voff) do { _Pragma("unroll") for (int _i = 0; _i < 2; ++_i) \
        __builtin_amdgcn_global_load_lds((const unsigned*)((const char*)(gbase) + (voff)[_i]), (PG8_LAS unsigned*)(lds + (bufoff) + ldsw + _i * 8192), 16, 0, 0); } while (0)
#define PG8_LDA(dst, b, h) do { _Pragma("unroll") for (int m = 0; m < 4; ++m) _Pragma("unroll") for (int k = 0; k < 2; ++k) dst[m][k] = *(const PG8_LAS bf16x8*)(lds + PG8_SA(b, h) + aoff + m * 2048 + k * 1024); } while (0)
#define PG8_LDB(dst, b, h) do { _Pragma("unroll") for (int n = 0; n < 2; ++n) _Pragma("unroll") for (int k = 0; k < 2; ++k) dst[n][k] = *(const PG8_LAS bf16x8*)(lds + PG8_SB(b, h) + boff + n * 2048 + k * 1024); } while (0)
#define PG8_MMA(ai, bj, At, Bt) do { __builtin_amdgcn_s_setprio(1); _Pragma("unroll") for (int m = 0; m < 4; ++m) _Pragma("unroll") for (int n = 0; n < 2; ++n) _Pragma("unroll") for (int k = 0; k < 2; ++k) \
        acc[ai][bj][m][n] = __builtin_amdgcn_mfma_f32_16x16x32_bf16(Bt[n][k], At[m][k], acc[ai][bj][m][n], 0, 0, 0); __builtin_amdgcn_s_setprio(0); } while (0)
#define PG8_WAIT_V(n) asm volatile("s_waitcnt vmcnt(" #n ")" ::: "memory")
#define PG8_WAIT_L(n) asm volatile("s_waitcnt lgkmcnt(" #n ")" ::: "memory")
#define PG8_BAR __builtin_amdgcn_s_barrier()
#define PG8_SCHED __builtin_amdgcn_sched_barrier(0)
    Unit cur, nxt; int ui = 0;
    if (!S.next(0, cur)) return;
    f32x4 acc[2][2][4][2];
#pragma unroll
    for (int a = 0; a < 2; ++a)
#pragma unroll
        for (int b = 0; b < 2; ++b)
#pragma unroll
            for (int m = 0; m < 4; ++m)
#pragma unroll
                for (int n = 0; n < 2; ++n) acc[a][b][m][n] = (f32x4){0.f, 0.f, 0.f, 0.f};
    bf16x8 At[4][2], B0[2][2], B1[2][2];
    const char* cA = (const char*)g.A + (size_t)cur.pm * tstep; const char* cB = (const char*)g.Bt + (size_t)cur.pn * tstep;
    S.a_ready(cur);
    if constexpr (SP2) {
        PG8_STAGE(PG8_SB(0, 0), cB, voffB); PG8_STAGE(PG8_SB(0, 1), cB + hstep, voffB); PG8_STAGE(PG8_SA(0, 0), cA, voffA); PG8_STAGE(PG8_SA(0, 1), cA + hstep, voffA);
        if (wr == 1) PG8_BAR;
        PG8_WAIT_V(2); PG8_BAR;
        PG8_STAGE(PG8_SB(1, 0), cB + kstep, voffB); PG8_STAGE(PG8_SA(1, 0), cA + kstep, voffA); PG8_STAGE(PG8_SB(1, 1), cB + hstep + kstep, voffB);
        PG8_WAIT_V(6); PG8_BAR;
    } else {
        PG8_STAGE(PG8_SB(0, 0), cB, voffB); PG8_STAGE(PG8_SA(0, 0), cA, voffA); PG8_STAGE(PG8_SB(0, 1), cB + hstep, voffB); PG8_STAGE(PG8_SA(0, 1), cA + hstep, voffA);
        if (wr == 1) PG8_BAR;
        PG8_WAIT_V(4); PG8_BAR;
        PG8_STAGE(PG8_SB(1, 0), cB + kstep, voffB); PG8_STAGE(PG8_SA(1, 0), cA + kstep, voffA); PG8_STAGE(PG8_SB(1, 1), cB + hstep + kstep, voffB);
        PG8_WAIT_V(6); PG8_BAR;
    }
    for (;;) {
        const bool has_next = S.next(ui + 1, nxt);
        const char* nA = has_next ? (const char*)g.A + (size_t)nxt.pm * tstep : cA; const char* nB = has_next ? (const char*)g.Bt + (size_t)nxt.pn * tstep : cB;
        for (int t = 0; t < nt; t += 2) {
            const bool last = (t == nt - 2);
            const char* a1 = cA + (size_t)(t + 1) * kstep;
            const char* a2 = last ? nA : cA + (size_t)(t + 2) * kstep; const char* b2 = last ? nB : cB + (size_t)(t + 2) * kstep;
            const char* a3 = a2 + kstep; const char* b3 = b2 + kstep;
            if (last && has_next) S.a_ready(nxt);
            if constexpr (SP2) {
            PG8_LDB(B0, 0, 0); PG8_LDB(B1, 0, 1); PG8_SCHED; PG8_LDA(At, 0, 0); PG8_STAGE(PG8_SA(1, 1), a1 + hstep, voffA);
            PG8_WAIT_V(8); PG8_WAIT_L(0); PG8_BAR; PG8_MMA(0, 0, At, B0); PG8_MMA(0, 1, At, B1); PG8_BAR; PG8_SCHED;
            PG8_LDA(At, 0, 1); PG8_STAGE(PG8_SB(0, 0), b2, voffB); PG8_STAGE(PG8_SB(0, 1), b2 + hstep, voffB); PG8_STAGE(PG8_SA(0, 0), a2, voffA);
            PG8_WAIT_V(8); PG8_WAIT_L(0); PG8_BAR; PG8_MMA(1, 0, At, B0); PG8_MMA(1, 1, At, B1); PG8_BAR; PG8_SCHED;
            PG8_LDB(B0, 1, 0); PG8_LDB(B1, 1, 1); PG8_SCHED; PG8_LDA(At, 1, 0); PG8_STAGE(PG8_SA(0, 1), a2 + hstep, voffA);
            PG8_WAIT_V(8); PG8_WAIT_L(0); PG8_BAR; PG8_MMA(0, 0, At, B0); PG8_MMA(0, 1, At, B1); PG8_BAR; PG8_SCHED;
            PG8_LDA(At, 1, 1); PG8_STAGE(PG8_SB(1, 0), b3, voffB); PG8_STAGE(PG8_SB(1, 1), b3 + hstep, voffB); PG8_STAGE(PG8_SA(1, 0), a3, voffA);
            PG8_WAIT_V(8); PG8_WAIT_L(0); PG8_BAR; PG8_MMA(1, 0, At, B0); PG8_MMA(1, 1, At, B1); PG8_BAR; PG8_SCHED;
            } else {
            PG8_LDB(B0, 0, 0); PG8_SCHED; PG8_LDA(At, 0, 0); PG8_STAGE(PG8_SA(1, 1), a1 + hstep, voffA);
            PG8_WAIT_L(8); PG8_BAR; PG8_WAIT_L(0); PG8_MMA(0, 0, At, B0); PG8_BAR; PG8_SCHED;
            PG8_LDB(B1, 0, 1); PG8_STAGE(PG8_SB(0, 0), b2, voffB);
            PG8_BAR; PG8_WAIT_L(0); PG8_MMA(0, 1, At, B1); PG8_BAR;
            PG8_LDA(At, 0, 1); PG8_STAGE(PG8_SA(0, 0), a2, voffA);
            PG8_BAR; PG8_WAIT_L(0); PG8_MMA(1, 0, At, B0); PG8_BAR; PG8_SCHED;
            PG8_STAGE(PG8_SB(0, 1), b2 + hstep, voffB);
            PG8_WAIT_V(6); PG8_BAR; PG8_MMA(1, 1, At, B1); PG8_BAR;
            PG8_LDB(B0, 1, 0); PG8_SCHED; PG8_LDA(At, 1, 0); PG8_STAGE(PG8_SA(0, 1), a2 + hstep, voffA);
            PG8_WAIT_L(8); PG8_BAR; PG8_WAIT_L(0); PG8_MMA(0, 0, At, B0); PG8_BAR; PG8_SCHED;
            PG8_LDB(B1, 1, 1); PG8_STAGE(PG8_SB(1, 0), b3, voffB);
            PG8_BAR; PG8_WAIT_L(0); PG8_MMA(0, 1, At, B1); PG8_BAR;
            PG8_LDA(At, 1, 1); PG8_STAGE(PG8_SA(1, 0), a3, voffA);
            PG8_BAR; PG8_WAIT_L(0); PG8_MMA(1, 0, At, B0); PG8_BAR; PG8_SCHED;
            PG8_STAGE(PG8_SB(1, 1), b3 + hstep, voffB);
            PG8_WAIT_V(6); PG8_BAR; PG8_MMA(1, 1, At, B1); PG8_BAR;
            }
        }
        if constexpr (ALIGN_EPI) { if (wr == 0) PG8_BAR; }
        if constexpr (!Epi::AFTER_DRAIN) { E(acc, cur, wr, wc, fr, fq); S.done(cur); }
        if (!has_next) break;
#pragma unroll
        for (int a = 0; a < 2; ++a)
#pragma unroll
            for (int b = 0; b < 2; ++b)
#pragma unroll
                for (int m = 0; m < 4; ++m)
#pragma unroll
                    for (int n = 0; n < 2; ++n) acc[a][b][m][n] = (f32x4){0.f, 0.f, 0.f, 0.f};
        cur = nxt; cA = nA; cB = nB; ++ui;
        if constexpr (ALIGN_EPI) { if (wr == 1) PG8_BAR; }
    }
    PG8_WAIT_V(0);
    if constexpr (!ALIGN_EPI) { if (wr == 0) PG8_BAR; }
    PG8_BAR;
    if constexpr (Epi::AFTER_DRAIN) { E.fused(acc, cur, wr, wc, fr, fq, lds, wid, lane); S.done(cur); }
#undef PG8_SA
#undef PG8_SB
#undef PG8_STAGE
#undef PG8_LDA
#undef PG8_LDB
#undef PG8_MMA
#undef PG8_WAIT_V
#undef PG8_WAIT_L
#undef PG8_BAR
#undef PG8_SCHED
}
}
__device__ __forceinline__ void mod_item(const Params& p, int item, unsigned char* lds) {
    const int l = item / 48, cb = item % 48, t = otid(), lane = t & 63, w = t >> 6;
    float* sc = (float*)lds; float* red = sc + 9 * 1024;
    for (int i = t; i < 9 * 1024; i += 512) { const int b = i >> 10, k = i & 1023; const float v = b < 8 ? p.c[b * 1024 + k] : p.c_ctx[k]; sc[i] = silu(v); }
    __syncthreads();
    const float* wm = p.w_mod + (size_t)l * 1024 * 3072 + cb * 64 + lane;
    float acc[9];
#pragma unroll
    for (int b = 0; b < 9; ++b) acc[b] = 0.f;
#pragma unroll 16
    for (int k = w * 128; k < w * 128 + 128; ++k) { const float wv = wm[(size_t)k * 3072];
#pragma unroll
        for (int b = 0; b < 9; ++b) acc[b] += sc[b * 1024 + k] * wv; }
#pragma unroll
    for (int b = 0; b < 9; ++b) red[(w * 9 + b) * 64 + lane] = acc[b];
    __syncthreads();
    float* mod = (float*)(p.ws + WS_MOD);
    for (int i = t; i < 576; i += 512) { const int b = i >> 6, c = i & 63; float s = 0.f;
#pragma unroll
        for (int w2 = 0; w2 < 8; ++w2) s += red[(w2 * 9 + b) * 64 + c];
        mod[((size_t)l * 9 + b) * 3072 + cb * 64 + c] = s + p.b_mod[l * 3072 + cb * 64 + c]; }
    __syncthreads();
}
struct TJob { const float* src; bf16_t* dst; int spitch, dpitch, nvalid; };
__device__ __forceinline__ TJob tjob(const Params& p, int it) {
    constexpr int N_WIN = 2 * 168 * 16, N_R = 32, N_BR = 1024;
    bf16_t* Win_t = (bf16_t*)(p.ws + WS_WIN); bf16_t* Wr_t = (bf16_t*)(p.ws + WS_WR); bf16_t* Wbr_t = (bf16_t*)(p.ws + WS_WBR); bf16_t* Wout_t = (bf16_t*)(p.ws + WS_WOUT);
    TJob j;
    if (it < N_WIN) { const int l = it / 2688, rem = it % 2688, nt = rem / 16, kt = rem % 16, n0 = nt * 64; const SubInfo si = sub_info(n0);
        int oc = si.orig0 + (n0 - si.col0);
        if (si.col0 == C_GLU) { const int jj = n0 - C_GLU; oc = si.orig0 + ((jj & 255) >> 7) * 512 + (jj >> 8) * 128 + (jj & 127); }
        j.src = p.w_in + (size_t)l * 1024 * WIN_COLS + (size_t)(kt * 64) * WIN_COLS + oc; j.spitch = WIN_COLS; j.nvalid = 64;
        j.dst = Win_t + (size_t)l * NCOL * 1024 + (size_t)n0 * 1024 + kt * 64; j.dpitch = 1024; return j; }
    it -= N_WIN;
    if (it < N_R) { const int l = it / 16, kt = it % 16;
        j.src = p.w_in + (size_t)l * 1024 * WIN_COLS + (size_t)(kt * 64) * WIN_COLS + 5120; j.spitch = WIN_COLS; j.nvalid = 32; j.dst = Wr_t + (size_t)l * 32 * 1024 + kt * 64; j.dpitch = 1024; return j; }
    it -= N_R;
    if (it < N_BR) { const int li = it / 128, rem = it % 128, kt = rem / 16, nt = rem % 16;
        j.src = p.w_br + ((size_t)li * 512 + kt * 64) * 1024 + nt * 64; j.spitch = 1024; j.nvalid = 64; j.dst = Wbr_t + ((size_t)li * 1024 + nt * 64) * 512 + kt * 64; j.dpitch = 512; return j; }
    it -= N_BR;
    { const int l = it / 256, rem = it % 256, kt = rem / 16, nt = rem % 16;
        j.src = p.w_out + ((size_t)l * 1024 + kt * 64) * 1024 + nt * 64; j.spitch = 1024; j.nvalid = 64; j.dst = Wout_t + ((size_t)l * 1024 + nt * 64) * 1024 + kt * 64; j.dpitch = 1024; return j; }
}
__device__ __forceinline__ void phase0(const Params& p, unsigned char* lds) {
    constexpr int N_T = 2 * 168 * 16 + 32 + 1024 + 512, N_MOD = 96;
    const int G = gridDim.x, bid = blockIdx.x;
    if (bid >= G - N_MOD || G < N_MOD) { for (int it = (G < N_MOD ? bid : bid - (G - N_MOD)); it < N_MOD; it += (G < N_MOD ? G : N_MOD)) mod_item(p, it, lds); }
    float* tile = (float*)lds;
    const int t = otid(), r = t >> 3, c8 = (t & 7) * 8;
    int it = bid, buf = 0;
    f32x4 a = {0.f, 0.f, 0.f, 0.f}, b = {0.f, 0.f, 0.f, 0.f};
    TJob cur = tjob(p, it < N_T ? it : 0);
    if (it < N_T && c8 < cur.nvalid) { a = *(const f32x4*)(cur.src + (size_t)r * cur.spitch + c8); b = *(const f32x4*)(cur.src + (size_t)r * cur.spitch + c8 + 4); }
    for (; it < N_T; it += G) {
        const int nit = it + G; f32x4 na = {0.f, 0.f, 0.f, 0.f}, nb = {0.f, 0.f, 0.f, 0.f};
        TJob nxt = tjob(p, nit < N_T ? nit : 0);
        if (nit < N_T && c8 < nxt.nvalid) { na = *(const f32x4*)(nxt.src + (size_t)r * nxt.spitch + c8); nb = *(const f32x4*)(nxt.src + (size_t)r * nxt.spitch + c8 + 4); }
        float* tb = tile + buf * (64 * 65);
        { float* tp = tb + r * 65 + c8; tp[0] = a[0]; tp[1] = a[1]; tp[2] = a[2]; tp[3] = a[3]; tp[4] = b[0]; tp[5] = b[1]; tp[6] = b[2]; tp[7] = b[3]; }
        __syncthreads();
        if (r < cur.nvalid) { u32x4 w;
            w.x = pk2(tb[(c8 + 0) * 65 + r], tb[(c8 + 1) * 65 + r]); w.y = pk2(tb[(c8 + 2) * 65 + r], tb[(c8 + 3) * 65 + r]);
            w.z = pk2(tb[(c8 + 4) * 65 + r], tb[(c8 + 5) * 65 + r]); w.w = pk2(tb[(c8 + 6) * 65 + r], tb[(c8 + 7) * 65 + r]);
            *(u32x4*)(cur.dst + (size_t)r * cur.dpitch + c8) = w; }
        cur = nxt; a = na; b = nb; buf ^= 1;
    }
    __syncthreads();
}

__device__ __forceinline__ void ln_phase(const Params& p, int mode, int l, int lu, int row0, int nrows, const float* __restrict__ hpre) {
    const int tid_ = otid(), lane = tid_ & 63, w = tid_ >> 6;
    const float* mod = (const float*)(p.ws + WS_MOD); bf16_t* U = (bf16_t*)(p.ws + WS_U); float* hctx = (float*)(p.ws + WS_HCTX);
    const int neff = mode == 2 ? (nrows / TPB) * SEQ : nrows, stride = gridDim.x * 8;
#define LN_ROW(i) (mode == 2 ? ((i) / SEQ) * TPB + CTX + (i) % SEQ : (i))
#define LN_SRC(rr) (mode == 0 ? h_in_row(p, 0, row0 + (rr)) : hpre + (size_t)(rr) * 1024)
    int ie = blockIdx.x * 8 + w;
    f32x4 nv[4];
#pragma unroll
    for (int q = 0; q < 4; ++q) nv[q] = (f32x4){0.f, 0.f, 0.f, 0.f};
    if (ie < neff) { const float* src = LN_SRC(LN_ROW(ie));
#pragma unroll
        for (int q = 0; q < 4; ++q) nv[q] = *(const f32x4*)(src + q * 256 + lane * 4); }
    for (; ie < neff; ie += stride) {
        const int rr = LN_ROW(ie), grow = row0 + rr, b = grow / TPB, s = grow % TPB; const bool isctx = s < CTX;
        f32x4 v[4];
#pragma unroll
        for (int q = 0; q < 4; ++q) v[q] = nv[q];
        if (ie + stride < neff) { const float* src = LN_SRC(LN_ROW(ie + stride));
#pragma unroll
            for (int q = 0; q < 4; ++q) nv[q] = *(const f32x4*)(src + q * 256 + lane * 4); }
        float s1 = 0.f;
#pragma unroll
        for (int q = 0; q < 4; ++q) s1 += (v[q][0] + v[q][1]) + (v[q][2] + v[q][3]);
        float mean = wave_sum(s1) * (1.f / 1024.f), s2 = 0.f;
#pragma unroll
        for (int q = 0; q < 4; ++q) { const f32x4 d = v[q] - mean; s2 += (d[0] * d[0] + d[1] * d[1]) + (d[2] * d[2] + d[3] * d[3]); }
        float rstd = rsqrtf(wave_sum(s2) * (1.f / 1024.f) + EPS);
        if (mode != 0) {
            float* hdst = isctx ? hctx + ((size_t)b * CTX + s) * 1024 : p.out + ((size_t)b * SEQ + (s - CTX)) * 1024;
#pragma unroll
            for (int q = 0; q < 4; ++q) { const int col = q * 256 + lane * 4;
                const f32x4 gg = *(const f32x4*)(p.ln_g + l * 1024 + col), bb = *(const f32x4*)(p.ln_b + l * 1024 + col);
                v[q] = (v[q] - mean) * rstd * gg + bb; *(f32x4*)(hdst + col) = v[q]; }
            if (mode == 2) continue;
            s1 = 0.f;
#pragma unroll
            for (int q = 0; q < 4; ++q) s1 += (v[q][0] + v[q][1]) + (v[q][2] + v[q][3]);
            mean = wave_sum(s1) * (1.f / 1024.f); s2 = 0.f;
#pragma unroll
            for (int q = 0; q < 4; ++q) { const f32x4 d = v[q] - mean; s2 += (d[0] * d[0] + d[1] * d[1]) + (d[2] * d[2] + d[3] * d[3]); }
            rstd = rsqrtf(wave_sum(s2) * (1.f / 1024.f) + EPS);
        }
        const float* md = mod + ((size_t)lu * 9 + (isctx ? 8 : b)) * 3072;
#pragma unroll
        for (int q = 0; q < 4; ++q) { const int col = q * 256 + lane * 4;
            const f32x4 sh = *(const f32x4*)(md + col), scl = *(const f32x4*)(md + 1024 + col);
            const f32x4 uu = (v[q] - mean) * rstd * (scl + 1.f) + sh;
            uint2 o; o.x = pk2(uu[0], uu[1]); o.y = pk2(uu[2], uu[3]);
            *(uint2*)(U + (size_t)grow * 1024 + col) = o; }
    }
#undef LN_ROW
#undef LN_SRC
}

__device__ __forceinline__ void r_items(const Params& p, int l, int g, unsigned char* lds) {
    const int tid_ = otid(), lane = tid_ & 63, w = tid_ >> 6, fr = lane & 15, fq = lane >> 4, tg = p.tg, nit = tg / 16;
    if ((int)blockIdx.x * 8 >= nit) return;
    const bf16_t* U = (const bf16_t*)(p.ws + WS_U) + (size_t)g * tg * 1024; float* R = (float*)(p.ws + WS_R) + (size_t)g * tg * 32;
    const bf16_t* W = (const bf16_t*)(p.ws + WS_WR) + (size_t)l * 32 * 1024;
    bf16_t* wl = (bf16_t*)lds;
    for (int i = tid_; i < 4096; i += 512) { const int n = i >> 7, k8 = (i & 127) * 8; *(u32x4*)(wl + n * 1032 + k8) = *(const u32x4*)(W + (size_t)n * 1024 + k8); }
    __syncthreads();
    for (int it = blockIdx.x * 8 + w; it < nit; it += gridDim.x * 8) {
        f32x4 a0 = {0.f, 0.f, 0.f, 0.f}, a1 = {0.f, 0.f, 0.f, 0.f};
        const bf16_t* up = U + (size_t)(it * 16 + fr) * 1024 + fq * 8;
#pragma unroll 1
        for (int kh = 0; kh < 2; ++kh) {
            bf16x8 av[16];
#pragma unroll
            for (int ks = 0; ks < 16; ++ks) av[ks] = *(const bf16x8*)(up + (kh * 16 + ks) * 32);
#pragma unroll
            for (int ks = 0; ks < 16; ++ks) { const int ko = (kh * 16 + ks) * 32 + fq * 8;
                const bf16x8 b0 = *(const bf16x8*)(wl + fr * 1032 + ko), b1 = *(const bf16x8*)(wl + (16 + fr) * 1032 + ko);
                a0 = __builtin_amdgcn_mfma_f32_16x16x32_bf16(av[ks], b0, a0, 0, 0, 0); a1 = __builtin_amdgcn_mfma_f32_16x16x32_bf16(av[ks], b1, a1, 0, 0, 0); }
        }
#pragma unroll
        for (int jj = 0; jj < 4; ++jj) { float* rp = R + (size_t)(it * 16 + fq * 4 + jj) * 32; rp[fr] = a0[jj]; rp[16 + fr] = a1[jj]; }
    }
    __syncthreads();
}
__device__ __forceinline__ void qk_prep(const Params& p, int l, bool dry = false) {
    const int tid_ = otid(), lane = tid_ & 63, w = tid_ >> 6, tg = p.tg;
    bf16_t* Aq = subbuf(p, C_AQ); bf16_t* Ak = subbuf(p, C_AK);
    const float qg0 = p.q_norm[l * 128 + 2 * lane], qg1 = p.q_norm[l * 128 + 2 * lane + 1], kg0 = p.k_norm[l * 128 + 2 * lane], kg1 = p.k_norm[l * 128 + 2 * lane + 1];
    const float inv = exp2f(-(float)(lane & 31) * (13.287712379549449f / 32.f)) * 0.15915494309189535f;
    for (int row = blockIdx.x * 8 + w; row < tg; row += gridDim.x * 8) {
        const int s = row % TPB; float cs = 1.f, sn = 0.f;
        if (s >= CTX) { const int t = s - CTX; const int pos = lane < 32 ? (t >> 6) : (t & 63); float rev = (float)pos * inv; rev -= floorf(rev);
            sn = __builtin_amdgcn_sinf(rev); cs = __builtin_amdgcn_cosf(rev); }
        unsigned pr[6];
#pragma unroll
        for (int hh = 0; hh < 6; ++hh) { const bf16_t* ptr = hh < 4 ? Aq + (size_t)row * 512 + hh * 128 + 2 * lane : Ak + (size_t)row * 256 + (hh - 4) * 128 + 2 * lane; pr[hh] = *(const unsigned*)ptr; }
#pragma unroll
        for (int hh = 0; hh < 6; ++hh) {
            bf16_t* ptr = hh < 4 ? Aq + (size_t)row * 512 + hh * 128 + 2 * lane : Ak + (size_t)row * 256 + (hh - 4) * 128 + 2 * lane;
            const float x0 = bf2f(pr[hh] & 0xffffu), x1 = bf2f(pr[hh] >> 16);
            const float ss = wave_sum(x0 * x0 + x1 * x1), rinv = rsqrtf(ss * (1.f / 128.f) + EPS);
            const float y0 = x0 * rinv * (hh < 4 ? qg0 : kg0), y1 = x1 * rinv * (hh < 4 ? qg1 : kg1);
            if (!dry) *(unsigned*)ptr = pk2(y0 * cs - y1 * sn, y0 * sn + y1 * cs);
        }
    }
}
__device__ __forceinline__ void short_conv(const Params& p, int l, bool dry = false) {
    const int tg = p.tg; const bf16_t* Bg = subbuf(p, C_BG); const bf16_t* Cg = subbuf(p, C_CG); const bf16_t* Xin = subbuf(p, C_XIN); bf16_t* Zb = subbuf(p, C_ZB);
    const float* wv = p.b_conv + l * 3 * 512;
    const int tid_ = otid();
    for (int idx = blockIdx.x * 512 + tid_; idx < tg * 64; idx += gridDim.x * 512) {
        const int row = idx >> 6, c8 = (idx & 63) * 8, s = row % TPB; const size_t o = (size_t)row * 512 + c8;
        const bool hp = (s != 0 && s != CTX), hn = (s != CTX - 1 && s != TPB - 1);
        const u32x4 zero = {0u, 0u, 0u, 0u};
        const u32x4 bg = *(const u32x4*)(Bg + o), zb = *(const u32x4*)(Zb + o), c1 = *(const u32x4*)(Cg + o), x1 = *(const u32x4*)(Xin + o);
        const u32x4 c0 = hp ? *(const u32x4*)(Cg + o - 512) : zero, x0 = hp ? *(const u32x4*)(Xin + o - 512) : zero;
        const u32x4 c2 = hn ? *(const u32x4*)(Cg + o + 512) : zero, x2 = hn ? *(const u32x4*)(Xin + o + 512) : zero;
        u32x4 ow;
#pragma unroll
        for (int e = 0; e < 4; ++e) {
            float res[2];
#pragma unroll
            for (int hl = 0; hl < 2; ++hl) { const int c = c8 + 2 * e + hl; const int sh = hl * 16;
                const float p0 = bf2f((c0[e] >> sh) & 0xffffu) * bf2f((x0[e] >> sh) & 0xffffu), p1 = bf2f((c1[e] >> sh) & 0xffffu) * bf2f((x1[e] >> sh) & 0xffffu),
                            p2 = bf2f((c2[e] >> sh) & 0xffffu) * bf2f((x2[e] >> sh) & 0xffffu);
                const float cv = wv[c] * p0 + wv[512 + c] * p1 + wv[1024 + c] * p2;
                res[hl] = bf2f((bg[e] >> sh) & 0xffffu) * cv * silu(bf2f((zb[e] >> sh) & 0xffffu)); }
            ow[e] = pk2(res[0], res[1]);
        }
        if (!dry) *(u32x4*)(Zb + o) = ow;
    }
}
__device__ __forceinline__ void conformer(const Params& p, int l, unsigned char* lds, bool dry = false) {
    const int tg = p.tg, c = otid(), lane = c & 63, w = c >> 6;
    float* hbuf = (float*)lds;
    bf16_t* vt = (bf16_t*)(lds + 32768);
    const bf16_t* Glu = subbuf(p, C_GLU); bf16_t* Zd = subbuf(p, C_ZD);
    float wk[31];
#pragma unroll
    for (int k = 0; k < 31; ++k) wk[k] = p.d_conv_w[((size_t)l * 31 + k) * 512 + c];
    const float bias = p.d_conv_b[l * 512 + c];
    for (int it = blockIdx.x; it < tg / 16; it += gridDim.x) {
        const int r0 = it * 16, s0 = r0 % TPB, bstart = r0 - s0;
        const int seg_lo = s0 < CTX ? bstart : bstart + CTX, seg_hi = s0 < CTX ? bstart + CTX : bstart + TPB;
#pragma unroll
        for (int k6 = 0; k6 < 6; ++k6) { const int idx = c + k6 * 512;
            if (idx < 46 * 64) { const int r = idx >> 6, c8 = (idx & 63) * 8, row = r0 - 15 + r; u32x4 val = {0u, 0u, 0u, 0u};
                if (row >= seg_lo && row < seg_hi) val = *(const u32x4*)(Glu + (size_t)row * 512 + c8);
                *(u32x4*)(vt + r * 512 + c8) = val; } }
        __syncthreads();
        float v[46];
#pragma unroll
        for (int i = 0; i < 46; ++i) v[i] = bf2f(vt[i * 512 + c]);
#pragma unroll
        for (int t = 0; t < 16; ++t) { float hh = bias;
#pragma unroll
            for (int k = 0; k < 31; ++k) hh += wk[k] * v[t + k];
            hbuf[t * 512 + c] = hh; }
        __syncthreads();
#pragma unroll
        for (int tt = 0; tt < 2; ++tt) { const int t = 2 * w + tt, c8 = lane * 8;
            const f32x4 a = *(const f32x4*)(hbuf + t * 512 + c8), b = *(const f32x4*)(hbuf + t * 512 + c8 + 4);
            const float mean = wave_sum((a[0] + a[1]) + (a[2] + a[3]) + (b[0] + b[1]) + (b[2] + b[3])) * (1.f / 512.f);
            const f32x4 da = a - mean, db = b - mean;
            const float var = wave_sum((da[0] * da[0] + da[1] * da[1]) + (da[2] * da[2] + da[3] * da[3]) + (db[0] * db[0] + db[1] * db[1]) + (db[2] * db[2] + db[3] * db[3])) * (1.f / 512.f);
            const float rstd = rsqrtf(var + EPS);
            const float* gp = p.d_norm_g + l * 512 + c8; const float* bp = p.d_norm_b + l * 512 + c8;
            const f32x4 g0 = *(const f32x4*)gp, g1 = *(const f32x4*)(gp + 4), b0 = *(const f32x4*)bp, b1 = *(const f32x4*)(bp + 4);
            const f32x4 y0 = da * rstd * g0 + b0, y1 = db * rstd * g1 + b1;
            bf16_t* zp = Zd + (size_t)(r0 + t) * 512 + c8; const u32x4 zw = *(const u32x4*)zp;
            u32x4 ow;
            ow.x = pk2(silu(y0[0]) * silu(bf2f(zw.x & 0xffffu)), silu(y0[1]) * silu(bf2f(zw.x >> 16)));
            ow.y = pk2(silu(y0[2]) * silu(bf2f(zw.y & 0xffffu)), silu(y0[3]) * silu(bf2f(zw.y >> 16)));
            ow.z = pk2(silu(y1[0]) * silu(bf2f(zw.z & 0xffffu)), silu(y1[1]) * silu(bf2f(zw.z >> 16)));
            ow.w = pk2(silu(y1[2]) * silu(bf2f(zw.w & 0xffffu)), silu(y1[3]) * silu(bf2f(zw.w >> 16)));
            if (!dry) *(u32x4*)zp = ow; }
        __syncthreads();
    }
}
#define GLA_PT 72
__device__ __forceinline__ int gla_cidx(int c, int dir) { return dir == 0 ? c : (c < 4 ? 3 - c : 39 - c); }
__device__ __forceinline__ void gla_gates(const float* rl, int pitch, const float (&w2c)[16], float b2, int dir, int w, int d, float* segtot, float (&cum)[8], float& tot) {
    float gl[8];
#pragma unroll
    for (int e = 0; e < 8; ++e) { const float* rp = rl + (w * 8 + e) * pitch; float z = b2;
#pragma unroll
        for (int m4 = 0; m4 < 4; ++m4) { const f32x4 rv = *(const f32x4*)(rp + m4 * 4); z += rv[0] * w2c[m4 * 4] + rv[1] * w2c[m4 * 4 + 1] + rv[2] * w2c[m4 * 4 + 2] + rv[3] * w2c[m4 * 4 + 3]; }
        gl[e] = (fminf(z, 0.f) - __logf(1.f + __expf(-fabsf(z)))) * (1.f / 16.f); }
    float run = 0.f;
    if (dir == 0) {
#pragma unroll
        for (int e = 0; e < 8; ++e) { run += gl[e]; cum[e] = run; }
    } else {
#pragma unroll
        for (int e = 7; e >= 0; --e) { run += gl[e]; cum[e] = run; }
    }
    segtot[w * 64 + d] = run;
    __syncthreads();
    float off = 0.f; tot = 0.f;
#pragma unroll
    for (int s2 = 0; s2 < 8; ++s2) { const float sv = segtot[s2 * 64 + d]; tot += sv; if (dir == 0 ? (s2 < w) : (s2 > w)) off += sv; }
#pragma unroll
    for (int e = 0; e < 8; ++e) cum[e] += off;
}
__device__ __forceinline__ float* gla_U(const Params& p) { return (float*)(p.ws + WS_P + (size_t)p.tg * NCOL * 2); }
__device__ __forceinline__ float* gla_Dk(const Params& p) { return (float*)(p.ws + WS_P + (size_t)p.tg * NCOL * 2 + (size_t)p.tg * 4096); }
__device__ __forceinline__ void gla_g1(const Params& p, int l, int g, int item, unsigned char* lds) {
    const int tid = otid(), lane = tid & 63, w = tid >> 6, fr = lane & 15, fq = lane >> 4, tg = p.tg, d = lane;
    const int c = item % 36, x = item / 36, dir = x & 1, h = (x >> 1) & 3, bl = x >> 3;
    const bf16_t* Ck = subbuf(p, C_CK); const bf16_t* Cv = subbuf(p, C_CV);
    const float* R = (const float*)(p.ws + WS_R) + (size_t)g * tg * 32;
    bf16_t* Kht = (bf16_t*)lds; bf16_t* Vt = Kht + 64 * GLA_PT; float* rl = (float*)(Vt + 128 * GLA_PT); float* segtot = rl + 1024;
    bf16_t* ks = (bf16_t*)(segtot + 512); float* wl = (float*)(ks + 64 * GLA_PT);
    const int base = bl * TPB + c * 64;
    *(u32x4*)(ks + (tid >> 3) * GLA_PT + (tid & 7) * 8) = *(const u32x4*)(Ck + (size_t)(base + (tid >> 3)) * 256 + h * 64 + (tid & 7) * 8);
    if (tid < 256) *(f32x4*)(wl + (tid >> 4) * 64 + (tid & 15) * 4) = *(const f32x4*)(p.c_gate_w2 + (((size_t)l * 2 + dir) * 16 + (tid >> 4)) * 256 + h * 64 + (tid & 15) * 4);
    const float b2 = p.c_gate_b[((size_t)l * 2 + dir) * 256 + h * 64 + d];
    u32x4 vc[2];
#pragma unroll
    for (int u2 = 0; u2 < 2; ++u2) { const int idx = tid + 512 * u2; vc[u2] = *(const u32x4*)(Cv + (size_t)(base + (idx >> 4)) * 512 + h * 128 + (idx & 15) * 8); }
    if (tid < 256) *(f32x4*)(rl + (tid >> 2) * 16 + (tid & 3) * 4) = *(const f32x4*)(R + (size_t)(base + (tid >> 2)) * 32 + dir * 16 + (tid & 3) * 4);
#pragma unroll
    for (int u2 = 0; u2 < 2; ++u2) { const int idx = tid + 512 * u2, j = idx >> 4, vg = idx & 15;
#pragma unroll
        for (int e = 0; e < 4; ++e) { Vt[(vg * 8 + 2 * e) * GLA_PT + j] = (bf16_t)(vc[u2][e] & 0xffffu); Vt[(vg * 8 + 2 * e + 1) * GLA_PT + j] = (bf16_t)(vc[u2][e] >> 16); } }
    __syncthreads();
    float w2c[16], kc[8];
#pragma unroll
    for (int m = 0; m < 16; ++m) w2c[m] = wl[m * 64 + d];
#pragma unroll
    for (int e = 0; e < 8; ++e) kc[e] = bf2f(ks[(w * 8 + e) * GLA_PT + d]);
    float cum[8], tot;
    gla_gates(rl, 16, w2c, b2, dir, w, d, segtot, cum, tot);
    { unsigned kh[8];
#pragma unroll
      for (int e = 0; e < 8; ++e) kh[e] = f2bf(kc[e] * __expf(tot - cum[e]));
      u32x4 kw; kw.x = kh[0] | (kh[1] << 16); kw.y = kh[2] | (kh[3] << 16); kw.z = kh[4] | (kh[5] << 16); kw.w = kh[6] | (kh[7] << 16);
      *(u32x4*)(Kht + d * GLA_PT + w * 8) = kw; }
    __syncthreads();
    const int uidx = x * 36 + gla_cidx(c, dir);
    float* Up = gla_U(p) + (size_t)uidx * 8192;
    bf16x8 aV[2];
#pragma unroll
    for (int ks = 0; ks < 2; ++ks) aV[ks] = *(const bf16x8*)(Vt + (w * 16 + fr) * GLA_PT + ks * 32 + fq * 8);
#pragma unroll
    for (int dt = 0; dt < 4; ++dt) { f32x4 acc = {0.f, 0.f, 0.f, 0.f};
#pragma unroll
        for (int ks = 0; ks < 2; ++ks) { const bf16x8 bK = *(const bf16x8*)(Kht + (dt * 16 + fr) * GLA_PT + ks * 32 + fq * 8); acc = __builtin_amdgcn_mfma_f32_16x16x32_bf16(aV[ks], bK, acc, 0, 0, 0); }
#pragma unroll
        for (int jj = 0; jj < 4; ++jj) Up[(w * 16 + fq * 4 + jj) * 64 + dt * 16 + fr] = acc[jj]; }
    if (w == 0) gla_Dk(p)[(size_t)uidx * 64 + d] = __expf(tot);
}
__device__ __forceinline__ void gla_g2(const Params& p, bool dry = false) {
    const int nchain = (p.tg / TPB) * 8, tid = otid();
    float* U = gla_U(p); const float* Dk = gla_Dk(p);
    for (int idx = blockIdx.x * 512 + tid; idx < nchain * 2048; idx += gridDim.x * 512) {
        const int x = idx >> 11, e4 = idx & 2047;
        float* up = U + (size_t)x * 36 * 8192 + e4 * 4; const float* dk = Dk + (size_t)x * 36 * 64 + (e4 & 15) * 4;
        f32x4 S = {0.f, 0.f, 0.f, 0.f};
#pragma unroll 1
        for (int cb = 0; cb < 36; cb += 12) {
            f32x4 t[12], dc[12];
#pragma unroll
            for (int i = 0; i < 12; ++i) { t[i] = *(const f32x4*)(up + (size_t)(cb + i) * 8192); dc[i] = *(const f32x4*)(dk + (cb + i) * 64); }
#pragma unroll
            for (int i = 0; i < 12; ++i) { if (!dry) *(f32x4*)(up + (size_t)(cb + i) * 8192) = S; S = dc[i] * S + t[i]; }
            if (dry && S[0] == 12345.678f) *(f32x4*)up = S;
        }
    }
}
__device__ __forceinline__ void gla_g3(const Params& p, int l, int g, int bl, int h, int c, unsigned char* lds, bool dry = false) {
    const int tid = otid(), lane = tid & 63, w = tid >> 6, fr = lane & 15, fq = lane >> 4, tg = p.tg, d = lane;
    const bf16_t* Cq = subbuf(p, C_CQ); const bf16_t* Ck = subbuf(p, C_CK); const bf16_t* Cv = subbuf(p, C_CV); bf16_t* Zc = subbuf(p, C_ZC);
    const float* R = (const float*)(p.ws + WS_R) + (size_t)g * tg * 32;
    bf16_t* Qt = (bf16_t*)lds; bf16_t* Kt = Qt + 64 * GLA_PT; bf16_t* As = Kt + 64 * GLA_PT; bf16_t* Vt = As + 64 * GLA_PT;
    float* rl = (float*)(Vt + 128 * GLA_PT); float* segtot = rl + 2048; float* part = segtot + 512;
    bf16_t* qs = (bf16_t*)(part + 512); bf16_t* ks = qs + 64 * GLA_PT; float* wl = (float*)(ks + 64 * GLA_PT); float* ot = wl + 2048;
    const int base = bl * TPB + c * 64;
    { const size_t o = (size_t)(base + (tid >> 3)) * 256 + h * 64 + (tid & 7) * 8;
      *(u32x4*)(qs + (tid >> 3) * GLA_PT + (tid & 7) * 8) = *(const u32x4*)(Cq + o); *(u32x4*)(ks + (tid >> 3) * GLA_PT + (tid & 7) * 8) = *(const u32x4*)(Ck + o);
      *(f32x4*)(wl + tid * 4) = *(const f32x4*)(p.c_gate_w2 + (((size_t)l * 2 + (tid >> 8)) * 16 + ((tid >> 4) & 15)) * 256 + h * 64 + (tid & 15) * 4); }
    u32x4 vc[2];
#pragma unroll
    for (int u2 = 0; u2 < 2; ++u2) { const int idx = tid + 512 * u2; vc[u2] = *(const u32x4*)(Cv + (size_t)(base + (idx >> 4)) * 512 + h * 128 + (idx & 15) * 8); }
    *(f32x4*)(rl + (tid >> 3) * 32 + (tid & 7) * 4) = *(const f32x4*)(R + (size_t)(base + (tid >> 3)) * 32 + (tid & 7) * 4);
#pragma unroll
    for (int u2 = 0; u2 < 2; ++u2) { const int idx = tid + 512 * u2, j = idx >> 4, vg = idx & 15;
#pragma unroll
        for (int e = 0; e < 4; ++e) { Vt[(vg * 8 + 2 * e) * GLA_PT + j] = (bf16_t)(vc[u2][e] & 0xffffu); Vt[(vg * 8 + 2 * e + 1) * GLA_PT + j] = (bf16_t)(vc[u2][e] >> 16); } }
    bf16x8 bSall[2][2];
#pragma unroll
    for (int dir = 0; dir < 2; ++dir) { const float* Sp = gla_U(p) + (size_t)(((bl * 4 + h) * 2 + dir) * 36 + gla_cidx(c, dir)) * 8192 + (w * 16 + fr) * 64 + fq * 8;
#pragma unroll
        for (int ks = 0; ks < 2; ++ks) { const f32x4 s0 = *(const f32x4*)(Sp + ks * 32), s1 = *(const f32x4*)(Sp + ks * 32 + 4);
            u32x4 sw; sw.x = pk2(s0[0], s0[1]); sw.y = pk2(s0[2], s0[3]); sw.z = pk2(s1[0], s1[1]); sw.w = pk2(s1[2], s1[3]); bSall[dir][ks] = __builtin_bit_cast(bf16x8, sw); } }
    f32x4 acc[4];
#pragma unroll
    for (int m = 0; m < 4; ++m) acc[m] = (f32x4){0.f, 0.f, 0.f, 0.f};
    __syncthreads();
    float qc[8], kc[8];
#pragma unroll
    for (int e = 0; e < 8; ++e) { qc[e] = bf2f(qs[(w * 8 + e) * GLA_PT + d]) * 0.125f; kc[e] = bf2f(ks[(w * 8 + e) * GLA_PT + d]); }
#pragma unroll
    for (int dir = 0; dir < 2; ++dir) {
        float w2c[16];
#pragma unroll
        for (int m = 0; m < 16; ++m) w2c[m] = wl[(dir * 16 + m) * 64 + d];
        const float b2 = p.c_gate_b[((size_t)l * 2 + dir) * 256 + h * 64 + d];
        const bf16x8 bS[2] = {bSall[dir][0], bSall[dir][1]};
        __syncthreads();
        float cum[8], tot;
        gla_gates(rl + dir * 16, 32, w2c, b2, dir, w, d, segtot, cum, tot);
#pragma unroll
        for (int e = 0; e < 8; ++e) { const int i = w * 8 + e; Qt[i * GLA_PT + d] = (bf16_t)f2bf(qc[e] * __expf(cum[e])); Kt[i * GLA_PT + d] = (bf16_t)f2bf(kc[e] * __expf(-cum[e])); }
        __syncthreads();
        { const int m = w >> 1;
#pragma unroll
          for (int nn = 0; nn < 2; ++nn) { const int n = (w & 1) * 2 + nn; f32x4 sc = {0.f, 0.f, 0.f, 0.f};
#pragma unroll
              for (int ks = 0; ks < 2; ++ks) { const bf16x8 a = *(const bf16x8*)(Qt + (m * 16 + fr) * GLA_PT + ks * 32 + fq * 8), b = *(const bf16x8*)(Kt + (n * 16 + fr) * GLA_PT + ks * 32 + fq * 8);
                  sc = __builtin_amdgcn_mfma_f32_16x16x32_bf16(a, b, sc, 0, 0, 0); }
#pragma unroll
              for (int jj = 0; jj < 4; ++jj) { const int i = m * 16 + fq * 4 + jj, j = n * 16 + fr; const bool keep = dir == 0 ? (j <= i) : (j >= i);
                  As[i * GLA_PT + j] = keep ? (bf16_t)f2bf(sc[jj]) : (bf16_t)0; } } }
        __syncthreads();
        bf16x8 bV[2];
#pragma unroll
        for (int ks = 0; ks < 2; ++ks) bV[ks] = *(const bf16x8*)(Vt + (w * 16 + fr) * GLA_PT + ks * 32 + fq * 8);
#pragma unroll
        for (int m = 0; m < 4; ++m) {
#pragma unroll
            for (int ks = 0; ks < 2; ++ks) { const bf16x8 aA = *(const bf16x8*)(As + (m * 16 + fr) * GLA_PT + ks * 32 + fq * 8), aQ = *(const bf16x8*)(Qt + (m * 16 + fr) * GLA_PT + ks * 32 + fq * 8);
                acc[m] = __builtin_amdgcn_mfma_f32_16x16x32_bf16(aA, bV[ks], acc[m], 0, 0, 0); acc[m] = __builtin_amdgcn_mfma_f32_16x16x32_bf16(aQ, bS[ks], acc[m], 0, 0, 0); } }
    }
#pragma unroll
    for (int m = 0; m < 4; ++m)
#pragma unroll
        for (int jj = 0; jj < 4; ++jj) { float sq = acc[m][jj] * acc[m][jj]; sq += __shfl_xor(sq, 1); sq += __shfl_xor(sq, 2); sq += __shfl_xor(sq, 4); sq += __shfl_xor(sq, 8);
            if (fr == 0) part[w * 64 + m * 16 + fq * 4 + jj] = sq; }
    __syncthreads();
    const float cn = p.c_norm[l * 512 + h * 128 + w * 16 + fr];
#pragma unroll
    for (int m = 0; m < 4; ++m)
#pragma unroll
        for (int jj = 0; jj < 4; ++jj) { const int row = m * 16 + fq * 4 + jj; float ss = 0.f;
#pragma unroll
            for (int w2 = 0; w2 < 8; ++w2) ss += part[w2 * 64 + row];
            ot[row * 132 + w * 16 + fr] = acc[m][jj] * rsqrtf(ss * (1.f / 128.f) + EPS) * cn; }
    __syncthreads();
#pragma unroll
    for (int u2 = 0; u2 < 2; ++u2) { const int idx = tid + 512 * u2, row = idx >> 4, c8 = (idx & 15) * 8;
        bf16_t* zp = Zc + (size_t)(base + row) * 512 + h * 128 + c8; const u32x4 zw = *(const u32x4*)zp;
        const f32x4 o0 = *(const f32x4*)(ot + row * 132 + c8), o1 = *(const f32x4*)(ot + row * 132 + c8 + 4);
        u32x4 ow;
        ow.x = pk2(o0[0] * silu(bf2f(zw.x & 0xffffu)), o0[1] * silu(bf2f(zw.x >> 16))); ow.y = pk2(o0[2] * silu(bf2f(zw.y & 0xffffu)), o0[3] * silu(bf2f(zw.y >> 16)));
        ow.z = pk2(o1[0] * silu(bf2f(zw.z & 0xffffu)), o1[1] * silu(bf2f(zw.z >> 16))); ow.w = pk2(o1[2] * silu(bf2f(zw.w & 0xffffu)), o1[3] * silu(bf2f(zw.w >> 16)));
        if (!dry) *(u32x4*)zp = ow; }
}
#define LAS __attribute__((address_space(3)))
#define XB_TMO      128
#define XB_XCNT(j)  (256  + 64 * (j))
#define XB_XSUB(j)  (1280 + 64 * (j))
#define XB_XGEN(j)  (2304 + 64 * (j))
#define XB_TOP      3328
#define XB_TOPGEN   3392
#define XCD_BAR_WORDS 3456
#define XB_SPIN_CAP (1u << 18)

__device__ __forceinline__ unsigned xb_ld(unsigned* p)              { return __hip_atomic_load(p, __ATOMIC_RELAXED, __HIP_MEMORY_SCOPE_AGENT); }
__device__ __forceinline__ unsigned xb_add(unsigned* p, unsigned v) { return __hip_atomic_fetch_add(p, v, __ATOMIC_RELAXED, __HIP_MEMORY_SCOPE_AGENT); }
__device__ __forceinline__ unsigned xb_xcc_id() { return (unsigned)__builtin_amdgcn_s_getreg((3 << 11) | 20) & 0xFu; }
#define XB_SPIN(cond, bar) do { unsigned _sp = 0; while (cond) { __builtin_amdgcn_s_sleep(1); \
    if ((++_sp & 255u) == 0u) { if (xb_ld(&(bar)[XB_TMO])) break; if (_sp > XB_SPIN_CAP) { atomicAdd(&(bar)[XB_TMO], 1u); break; } } } } while (0)

struct XcdBarrier {
    unsigned* bar; unsigned x;
    volatile LAS unsigned* st;
};

__device__ __forceinline__ XcdBarrier xcd_barrier_post(unsigned* bar, volatile LAS unsigned* st) {
    XcdBarrier b; b.bar = bar; b.x = xb_xcc_id(); b.st = st;
    if (threadIdx.x == 0) (void)xb_add(&bar[XB_XCNT(b.x)], 1u);
    return b;
}
__device__ __forceinline__ void xcd_barrier_complete(unsigned* bar, unsigned x, unsigned& nloc, unsigned& nx) {
    const unsigned G = gridDim.x * gridDim.y * gridDim.z;
    unsigned sum, cnt, mine, sp = 0u;
    for (;;) {
        sum = 0u; cnt = 0u; mine = 0u;
#pragma unroll
        for (unsigned j = 0; j < 16; ++j) { const unsigned c = xb_ld(&bar[XB_XCNT(j)]); sum += c; cnt += (c > 0u) ? 1u : 0u; mine = (j == x) ? c : mine; }
        if (sum == G) break;
        __builtin_amdgcn_s_sleep(1);
        if ((++sp & 255u) == 0u) { if (xb_ld(&bar[XB_TMO])) break; if (sp > XB_SPIN_CAP) { atomicAdd(&bar[XB_TMO], 1u); break; } }
    }
    nloc = mine > 0u ? mine : 1u; nx = cnt > 0u ? cnt : 1u;
}

__device__ __forceinline__ void xcd_barrier(const XcdBarrier& b) {
    asm volatile("s_waitcnt vmcnt(0)" ::: "memory");
    __syncthreads();
    if (threadIdx.x == 0) {
        unsigned* bar = b.bar;
        __builtin_amdgcn_s_waitcnt(0);
        unsigned nloc = b.st[0], nx = b.st[1];
        if (nloc == 0u) { xcd_barrier_complete(bar, b.x, nloc, nx); b.st[0] = nloc; b.st[1] = nx; }
        const unsigned old = xb_add(&bar[XB_XSUB(b.x)], 1u);
        const unsigned gen = old / nloc;
        if (old + 1u == (gen + 1u) * nloc) {
            __builtin_amdgcn_fence(__ATOMIC_RELEASE, "agent");
            asm volatile("s_waitcnt vmcnt(0)" ::: "memory");
            const unsigned og = xb_add(&bar[XB_TOP], 1u);
            const unsigned tg = og / nx;
            if (og + 1u == (tg + 1u) * nx) xb_add(&bar[XB_TOPGEN], 1u);
            else XB_SPIN(xb_ld(&bar[XB_TOPGEN]) == tg, bar);
            __builtin_amdgcn_fence(__ATOMIC_ACQUIRE, "agent");
            xb_add(&bar[XB_XGEN(b.x)], 1u);
            asm volatile("s_waitcnt vmcnt(0)" ::: "memory");
        } else {
            XB_SPIN(xb_ld(&bar[XB_XGEN(b.x)]) == gen, bar);
            __builtin_amdgcn_fence(__ATOMIC_ACQUIRE, "agent");
            asm volatile("s_waitcnt vmcnt(0)" ::: "memory");
        }
    }
    __syncthreads();
}
__device__ __forceinline__ void sum_branches(const Params& p, const bf16_t* Gb, bf16_t* merged) {
    const int tid_ = otid(); const size_t n8 = (size_t)p.tg * 128, gs = (size_t)p.tg * 1024;
    for (size_t i = (size_t)blockIdx.x * 512 + tid_; i < n8; i += (size_t)gridDim.x * 512) {
        const u32x4 a = *(const u32x4*)(Gb + i * 8), b = *(const u32x4*)(Gb + gs + i * 8), c = *(const u32x4*)(Gb + 2 * gs + i * 8), d = *(const u32x4*)(Gb + 3 * gs + i * 8);
        u32x4 o;
#pragma unroll
        for (int e = 0; e < 4; ++e) {
            const float lo = (bf2f(a[e] & 0xffffu) + bf2f(b[e] & 0xffffu)) + (bf2f(c[e] & 0xffffu) + bf2f(d[e] & 0xffffu));
            const float hi = (bf2f(a[e] >> 16) + bf2f(b[e] >> 16)) + (bf2f(c[e] >> 16) + bf2f(d[e] >> 16));
            o[e] = pk2(lo, hi); }
        *(u32x4*)(merged + i * 8) = o;
    }
}
__global__ void __launch_bounds__(512, 2) hybrid_block_fwd(Params p) {
    extern __shared__ __attribute__((aligned(16))) unsigned char lds[];
    cg::grid_group grid = cg::this_grid();
    if (p.ng < 0) grid.sync();
    volatile LAS unsigned* xst = (volatile LAS unsigned*)((LAS unsigned char*)lds + 131072);
    if (threadIdx.x < 2) xst[threadIdx.x] = 0u;
    __syncthreads();
    XcdBarrier xbar = xcd_barrier_post((unsigned*)(p.ws + WS_BAR), xst);
    const int tg = p.tg, G = gridDim.x, bid = blockIdx.x, nb = tg / TPB, tpg = tg / 256;
    const bool dryflag = p.ng > 0;
#if PROBING
    unsigned accA = 0, accB = 0; unsigned long long tprev = __builtin_amdgcn_s_memrealtime();
#define STAMP(k) do { const unsigned long long _now = __builtin_amdgcn_s_memrealtime(); if ((k) == PROBE_A) accA += (unsigned)(_now - tprev); if ((k) == PROBE_B) accB += (unsigned)(_now - tprev); tprev = _now; } while (0)
#else
#define STAMP(k) do { } while (0)
#endif
#if PH & 1
    phase0(p, lds);
#endif
#if REP & 8
    GSYNC(); phase0(p, lds);
#endif
    GSYNC(); STAMP(0);
#if PH & 2
    ln_phase(p, 0, 0, 0, 0, NTOK, nullptr);
#endif
    GSYNC(); STAMP(1);
#pragma unroll 1
    for (int l = 0; l < 2; ++l) {
#pragma unroll 1
        for (int g = 0; g < p.ng; ++g) {
            const bool last = (l == 1);
            r_items(p, l, g, lds);
            {
                pg8::Gemm gm{(const bf16_t*)(p.ws + WS_U) + (size_t)g * tg * 1024, (const bf16_t*)(p.ws + WS_WIN) + (size_t)l * NCOL * 1024, tg, NCOL, 1024};
                pg8::StaticOrder S; S.init(tg, NCOL, G, bid);
                pg8::EpiP E{p.ws + WS_P, tg};
#if PH & 4
                pg8::gemm_phase<pg8::EpiP, pg8::StaticOrder, true, true>((PG8_LAS unsigned char*)lds, gm, S, E);
#endif
#if REP & 16
                GSYNC();
                pg8::gemm_phase<pg8::EpiP, pg8::StaticOrder, true, true>((PG8_LAS unsigned char*)lds, gm, S, E);
#endif
            }
            GSYNC(); STAMP(2);
#if PH & 8
            qk_prep(p, l);
            short_conv(p, l);
            __syncthreads();
#endif
#if PH & 16
            conformer(p, l, lds);
#endif
            { const int n_g1 = nb * 8 * 36; for (int it = bid; it < n_g1; it += G) { __syncthreads(); gla_g1(p, l, g, it, lds); } }
            GSYNC();
#if REP & 1024
            conformer(p, l, lds, dryflag); GSYNC();
#endif
#if REP & 2048
            { const int n_g1 = nb * 8 * 36; for (int it = bid; it < n_g1; it += G) { __syncthreads(); gla_g1(p, l, g, it, lds); } } GSYNC();
#endif
#if REP & 128
            qk_prep(p, l, dryflag); short_conv(p, l, dryflag); __syncthreads(); conformer(p, l, lds, dryflag);
            { const int n_g1 = nb * 8 * 36; for (int it = bid; it < n_g1; it += G) { __syncthreads(); gla_g1(p, l, g, it, lds); } }
            GSYNC();
#endif
            gla_g2(p);
#if REP & 512
            GSYNC(); gla_g2(p, dryflag);
#endif
            GSYNC(); STAMP(3);
            {
                const int n_att_lat = nb * 32, n_ctx = last ? 0 : nb * 4, nck = last ? 32 : 36, c0 = last ? 4 : 0, n_g3 = nb * 4 * nck;
                const bf16_t* Aq = subbuf(p, C_AQ); const bf16_t* Ak = subbuf(p, C_AK); const bf16_t* Av = subbuf(p, C_AV); bf16_t* Za = subbuf(p, C_ZA);
                const bool split = G >= n_att_lat + 32;
                int it = bid; const int n_all = n_att_lat + n_ctx + n_g3;
                const int stride = split ? (bid < n_att_lat ? n_all : G - n_att_lat) : G;
                for (; it < n_all; it += stride) {
                    __syncthreads();
                    if (it >= n_att_lat + n_ctx) { const int a = it - n_att_lat - n_ctx, ci = a % nck, bh = a / nck; gla_g3(p, l, g, bh >> 2, bh & 3, c0 + ci, lds); continue; }
                    const int a = (it < n_att_lat && (n_att_lat & 7) == 0) ? (it & 7) * (n_att_lat >> 3) + (it >> 3) : it;
                    int bl, h, qrow0, seq;
                    if (a < n_att_lat) { bl = a >> 5; h = (a >> 3) & 3; qrow0 = bl * TPB + CTX + (a & 7) * 256; seq = TPB; }
                    else { const int a2 = a - n_att_lat; bl = a2 >> 2; h = a2 & 3; qrow0 = bl * TPB; seq = CTX; }
                    const size_t kvo = (size_t)(bl * TPB) * 256 + (h >> 1) * 128;
                    att::attn_dense_body((const att::bf16*)(Aq + (size_t)qrow0 * 512 + h * 128), (const att::bf16*)(Ak + kvo), (const att::bf16*)(Av + kvo),
                                         Za + (size_t)qrow0 * 512 + h * 128, seq, (char*)lds);
                }
            }
            GSYNC(); STAMP(4);
            bf16_t* Gbuf = (bf16_t*)(p.ws + WS_P);
            bf16_t* merged = (bf16_t*)(p.ws + WS_U) + (size_t)g * tg * 1024;
            {
                pg8::Gemm gm{subbuf(p, C_ZA), (const bf16_t*)(p.ws + WS_WBR) + (size_t)l * 4 * 1024 * 512, tg, 1024, 512};
                pg8::BrOrder2 S{tpg * 4, G, bid, tpg};
                pg8::EpiBr2 E{subbuf(p, C_MG), Gbuf, tpg, (size_t)tg * 1024};
                pg8::gemm_phase<pg8::EpiBr2, pg8::BrOrder2, true, true>((PG8_LAS unsigned char*)lds, gm, S, E);
            }
            GSYNC();
            sum_branches(p, Gbuf, merged);
            GSYNC(); STAMP(6);
            float* hpre = gla_U(p);
            {
                pg8::Gemm gm{merged, (const bf16_t*)(p.ws + WS_WOUT) + (size_t)l * 1024 * 1024, tg, 1024, 1024};
                pg8::StaticOrder S; S.init(tg, 1024, G, bid);
                pg8::EpiOut E{p, hpre, l, g};
#if PH & 512
                pg8::gemm_phase<pg8::EpiOut, pg8::StaticOrder, true, true>((PG8_LAS unsigned char*)lds, gm, S, E);
#endif
#if REP & 32
                GSYNC();
                pg8::gemm_phase<pg8::EpiOut, pg8::StaticOrder, true, true>((PG8_LAS unsigned char*)lds, gm, S, E);
#endif
            }
            GSYNC(); STAMP(7);
#if PH & 1024
            ln_phase(p, last ? 2 : 1, l, last ? 1 : l + 1, g * tg, tg, hpre);
#endif
        }
    }
#if PROBING
    if (bid == 0) { float* ex = (float*)lds; if (threadIdx.x == 0) { ex[0] = (float)accA * 0.01f; ex[1] = (float)accB * 0.001f; } __syncthreads();
        if (PROBE_A >= 0 && threadIdx.x == 0) p.out[0] = ex[0];
        if (PROBE_B >= 0) for (int i = threadIdx.x; i < 10000; i += 512) p.out[1024 + i] = ex[1]; }
#endif
}

extern "C" void kernel_launch(void* const* d_in, const int* in_sizes, int n_in, void* d_out, int out_size, void* d_ws, size_t ws_size, hipStream_t stream) {
    static int grid_blocks = 0;
    if (grid_blocks == 0) {
        int dev = 0, cus = 0, per_cu = 0;
        hipGetDevice(&dev);
        hipDeviceGetAttribute(&cus, hipDeviceAttributeMultiprocessorCount, dev);
        hipFuncSetAttribute((const void*)hybrid_block_fwd, hipFuncAttributeMaxDynamicSharedMemorySize, LDS_BYTES);
        hipOccupancyMaxActiveBlocksPerMultiprocessor(&per_cu, (const void*)hybrid_block_fwd, 512, LDS_BYTES);
        if (per_cu < 1) { fprintf(stderr, "kernel_launch: occupancy query reports %d blocks per CU\n", per_cu); per_cu = 1; }
        if (per_cu > 1) per_cu = 1;
        grid_blocks = cus * per_cu;
    }
    Params p{};
    const float** f = (const float**)&p;
    for (int i = 0; i < 21; ++i) f[i] = (const float*)d_in[i];
    p.out = (float*)d_out; p.ws = (unsigned char*)d_ws;
    p.ng = (ws_size >= WS_P + (size_t)9216 * (NCOL * 2 + 4096) + (1u << 20)) ? 2 : 4;
    p.tg = NTOK / p.ng;
    hipMemsetAsync((char*)d_ws + WS_BAR, 0, 16384, stream);
    void* args[] = {&p};
    hipError_t e = hipLaunchCooperativeKernel((const void*)hybrid_block_fwd, dim3(grid_blocks), dim3(512), args, LDS_BYTES, stream);
    if (e != hipSuccess) fprintf(stderr, "cooperative launch failed: %s (grid %d)\n", hipGetErrorString(e), grid_blocks);
}
```

```cpp
#include <hip/hip_runtime.h>
#include <hip/hip_bf16.h>
#include <hip/hip_cooperative_groups.h>
#include <cstdio>
#include <cstdint>
namespace cg = cooperative_groups;
#ifndef PH
#define PH 2047
#endif
#ifndef PROBE_A
#define PROBE_A -1
#endif
#ifndef PROBE_B
#define PROBE_B -1
#endif
#define PROBING (PROBE_A >= 0 || PROBE_B >= 0)
#ifndef REP
#define REP 0
#endif
#if REP & 4
#define GSYNC() do { xcd_barrier(xbar); xcd_barrier(xbar); } while (0)
#else
#define GSYNC() xcd_barrier(xbar)
#endif

constexpr int DM = 1024, NBATCH = 8, SEQ = 2048, CTX = 256, TPB = CTX + SEQ, NTOK = NBATCH * TPB;
constexpr int NCOL = 10752, WIN_COLS = 10784;
constexpr float EPS = 1e-6f, ALPHA = 1.41421356237f;
constexpr int C_BG = 0, C_CG = 512, C_XIN = 1024, C_GLU = 1536, C_AQ = 2560, C_AK = 3072, C_AV = 3328, C_CQ = 3584, C_CK = 3840, C_CV = 4096,
              C_ZA = 4608, C_ZB = 5120, C_ZC = 5632, C_ZD = 6144, C_MG = 6656;
constexpr size_t WS_WIN = 0;
constexpr size_t WS_WR = WS_WIN + (size_t)2 * NCOL * 1024 * 2;
constexpr size_t WS_WBR = WS_WR + (size_t)2 * 32 * 1024 * 2;
constexpr size_t WS_WOUT = WS_WBR + (size_t)2 * 4 * 1024 * 512 * 2;
constexpr size_t WS_MOD = WS_WOUT + (size_t)2 * 1024 * 1024 * 2;
constexpr size_t WS_U = WS_MOD + (size_t)2 * 9 * 3072 * 4;
constexpr size_t WS_R = WS_U + (size_t)NTOK * 1024 * 2;
constexpr size_t WS_HCTX = WS_R + (size_t)NTOK * 32 * 4;
constexpr size_t WS_BAR = WS_HCTX + (size_t)NBATCH * CTX * 1024 * 4;
constexpr size_t WS_P = WS_BAR + 16384;
constexpr int LDS_BYTES = 131072 + 1024;

typedef unsigned short bf16_t;
typedef short bf16x8 __attribute__((ext_vector_type(8)));
typedef float f32x4 __attribute__((ext_vector_type(4)));
typedef unsigned u32x4 __attribute__((ext_vector_type(4)));

struct Params {
    const float *x, *c, *ctx, *c_ctx, *w_mod, *b_mod, *w_in, *q_norm, *k_norm, *b_conv, *c_gate_w2, *c_gate_b, *c_norm,
                *d_conv_w, *d_conv_b, *d_norm_g, *d_norm_b, *w_br, *w_out, *ln_g, *ln_b;
    float* out; unsigned char* ws;
    int ng, tg;
};

__device__ __forceinline__ int otid() { int t = threadIdx.x; asm volatile("" : "+v"(t)); return t; }
__device__ __forceinline__ float bf2f(unsigned v) { return __uint_as_float(v << 16); }
__device__ __forceinline__ unsigned f2bf(float f) { unsigned u = __float_as_uint(f); return (u + 0x7fffu + ((u >> 16) & 1u)) >> 16; }
__device__ __forceinline__ unsigned pk2(float lo, float hi) { return f2bf(lo) | (f2bf(hi) << 16); }
__device__ __forceinline__ float sigm(float x) { return 1.f / (1.f + __expf(-x)); }
__device__ __forceinline__ float silu(float x) { return x / (1.f + __expf(-x)); }
__device__ __forceinline__ float wave_sum(float v) {
#pragma unroll
    for (int o = 32; o > 0; o >>= 1) v += __shfl_xor(v, o);
    return v;
}
__device__ __forceinline__ bf16_t* subbuf(const Params& p, int col) { return (bf16_t*)(p.ws + WS_P + (size_t)col * p.tg * 2); }
struct SubInfo { int col0, width, orig0; };
__device__ __forceinline__ SubInfo sub_info(int col) {
    if (col < 512) return {0, 512, 1536};
    if (col < 1024) return {512, 512, 2048};
    if (col < 1536) return {1024, 512, 2560};
    if (col < 2560) return {1536, 1024, 5152};
    if (col < 3072) return {2560, 512, 0};
    if (col < 3328) return {3072, 256, 512};
    if (col < 3584) return {3328, 256, 768};
    if (col < 3840) return {3584, 256, 3584};
    if (col < 4096) return {3840, 256, 3840};
    if (col < 4608) return {4096, 512, 4096};
    if (col < 5120) return {4608, 512, 1024};
    if (col < 5632) return {5120, 512, 3072};
    if (col < 6144) return {5632, 512, 4608};
    if (col < 6656) return {6144, 512, 6176};
    return {6656, 4096, 6688};
}
__device__ __forceinline__ const float* h_in_row(const Params& p, int l, int grow) {
    const int b = grow / TPB, s = grow % TPB;
    if (l == 0) return s < CTX ? p.ctx + ((size_t)b * CTX + s) * 1024 : p.x + ((size_t)b * SEQ + (s - CTX)) * 1024;
    return s < CTX ? (const float*)(p.ws + WS_HCTX) + ((size_t)b * CTX + s) * 1024 : p.out + ((size_t)b * SEQ + (s - CTX)) * 1024;
}
namespace att {
using bf16 = __hip_bfloat16;
constexpr int D = 128, NW = 8, QBLK = 32, KVBLK = 64;
constexpr float SCALE = 0.088388347648318440f;
constexpr float THR = 8.f;
constexpr int SDEPTH = 2;
constexpr int LDQ = 512, LDK = 256, LDZ = 512;
constexpr size_t SHM_V = KVBLK * D * 2, SHM_K = KVBLK * D * 2, SHM_ATTN = 2 * SHM_V + 2 * SHM_K + NW * 64 * 4;
using bf16x8 = __attribute__((ext_vector_type(8))) short;
using s16x4  = __attribute__((ext_vector_type(4))) short;
using f32x16 = __attribute__((ext_vector_type(16))) float;
using f32x8  = __attribute__((ext_vector_type(8))) float;
using u32x4  = __attribute__((ext_vector_type(4))) unsigned;
#define KSWZ(row, colB) ((row) * 256 + ((colB) ^ (((row) & 7) << 4)))
#define SBAR() __builtin_amdgcn_sched_barrier(0)
__device__ __forceinline__ int crow(int r, int hi) { return (r & 3) + 8 * (r >> 2) + 4 * hi; }
__device__ __forceinline__ unsigned cvtpk(float lo, float hi) {
  unsigned r; asm volatile("v_cvt_pk_bf16_f32 %0, %1, %2" : "=v"(r) : "v"(lo), "v"(hi)); return r;
}
template <typename TIn> struct Stage;
template <> struct Stage<bf16>  { using T = bf16x8;
  __device__ static __forceinline__ T ld8(const bf16* p) { return *reinterpret_cast<const bf16x8*>(p); }
  __device__ static __forceinline__ bf16x8 tobf(T x) { return x; } };
__device__ __forceinline__ void partialSM(f32x16& p0, f32x16& p1, float& m_reg, float& mn, float& alpha) {
  constexpr float C = SCALE * 1.4426950408889634f;
  float pmax = p0[0]; for (int r = 1; r < 16; ++r) pmax = fmaxf(pmax, p0[r]); for (int r = 0; r < 16; ++r) pmax = fmaxf(pmax, p1[r]);
  { auto rr = __builtin_amdgcn_permlane32_swap(__float_as_uint(pmax), __float_as_uint(pmax), false, false);
    pmax = fmaxf(__uint_as_float(rr[0]), __uint_as_float(rr[1])); }
  if (__builtin_expect(__all(pmax - m_reg <= THR / SCALE), 1)) { mn = m_reg; alpha = 1.f; }
  else { mn = fmaxf(m_reg, pmax); alpha = __builtin_amdgcn_exp2f((m_reg - mn) * C); m_reg = mn; }
  float mnC = -mn * C;
  for (int r = 0; r < 16; ++r) p0[r] = fmaf(p0[r], C, mnC); for (int r = 0; r < 16; ++r) p1[r] = fmaf(p1[r], C, mnC);
  for (int r = 0; r < 16; ++r) p0[r] = __builtin_amdgcn_exp2f(p0[r]);
}
__device__ __forceinline__ void finishSM(f32x16& p0, f32x16& p1, float alpha, float& l_reg, bf16x8& pa0, bf16x8& pa1, bf16x8& pa2, bf16x8& pa3) {
  for (int r = 0; r < 16; ++r) p1[r] = __builtin_amdgcn_exp2f(p1[r]);
  float ps = 0; for (int r = 0; r < 16; ++r) ps += p0[r]; for (int r = 0; r < 16; ++r) ps += p1[r];
  { auto rr = __builtin_amdgcn_permlane32_swap(__float_as_uint(ps), __float_as_uint(ps), false, false);
    ps = __uint_as_float(rr[0]) + __uint_as_float(rr[1]); }
  l_reg = l_reg * alpha + ps;
#define PK4(P, BASE, OUT) do { unsigned a0 = cvtpk(P[BASE + 0], P[BASE + 1]), a1 = cvtpk(P[BASE + 2], P[BASE + 3]);   \
    unsigned b0 = cvtpk(P[BASE + 4], P[BASE + 5]), b1 = cvtpk(P[BASE + 6], P[BASE + 7]);                              \
    auto r0 = __builtin_amdgcn_permlane32_swap(a0, b0, false, false); auto r1 = __builtin_amdgcn_permlane32_swap(a1, b1, false, false); \
    u32x4 w = {r0[0], r1[0], r0[1], r1[1]}; OUT = *reinterpret_cast<bf16x8*>(&w); } while (0)
  PK4(p0, 0, pa0); PK4(p0, 8, pa1); PK4(p1, 0, pa2); PK4(p1, 8, pa3);
#undef PK4
}
__device__ __forceinline__ void qkt(f32x16& p0, f32x16& p1, const bf16* Ks, const bf16x8* qr, int r32, int hi) {
  p0 = f32x16{}; p1 = f32x16{};
  for (int d0 = 0; d0 < 8; ++d0) { int cb = (d0 * 16 + hi * 8) * 2;
    bf16x8 b0 = *reinterpret_cast<const bf16x8*>((const char*)Ks + KSWZ(r32, cb));
    bf16x8 b1 = *reinterpret_cast<const bf16x8*>((const char*)Ks + KSWZ(32 + r32, cb));
    p0 = __builtin_amdgcn_mfma_f32_32x32x16_bf16(b0, qr[d0], p0, 0, 0, 0);
    p1 = __builtin_amdgcn_mfma_f32_32x32x16_bf16(b1, qr[d0], p1, 0, 0, 0); }
}
__device__ __forceinline__ int v_st(int k, int c) { const int kk = (k & ~0xC) | ((k & 4) << 1) | ((k & 8) >> 1); return ((kk >> 3) * 4 + (c >> 5)) * 512 + ((kk & 7) * 32 + (c & 31)) * 2; }
__device__ __forceinline__ int v_rd_base(int lane) { return ((lane & 3) << 3) | (((lane >> 2) & 3) << 6) | (((lane >> 4) & 1) << 5) | (((lane >> 5) & 1) << 8); }
constexpr int v_rd_off(int d0, int ks, int half) { return d0 * 512 + ks * 4096 + half * 2048; }
template <int OFF> __device__ __forceinline__ s16x4 tr_read(int vb) {
  s16x4 r; asm volatile("ds_read_b64_tr_b16 %0, %1 offset:%2" : "=&v"(r) : "v"(vb), "i"(OFF) : "memory"); return r;
}
template <int D0> __device__ __forceinline__ void pv_one(f32x16& od, int vb, bf16x8 pa0, bf16x8 pa1, bf16x8 pa2, bf16x8 pa3) {
  const s16x4 l0 = tr_read<v_rd_off(D0, 0, 0)>(vb), h0 = tr_read<v_rd_off(D0, 0, 1)>(vb), l1 = tr_read<v_rd_off(D0, 1, 0)>(vb), h1 = tr_read<v_rd_off(D0, 1, 1)>(vb);
  const s16x4 l2 = tr_read<v_rd_off(D0, 2, 0)>(vb), h2 = tr_read<v_rd_off(D0, 2, 1)>(vb), l3 = tr_read<v_rd_off(D0, 3, 0)>(vb), h3 = tr_read<v_rd_off(D0, 3, 1)>(vb);
  asm volatile("s_waitcnt lgkmcnt(0)" ::: "memory"); SBAR();
#define PK(L, H) (bf16x8){L[0], L[1], L[2], L[3], H[0], H[1], H[2], H[3]}
  od = __builtin_amdgcn_mfma_f32_32x32x16_bf16(pa0, PK(l0, h0), od, 0, 0, 0);
  od = __builtin_amdgcn_mfma_f32_32x32x16_bf16(pa1, PK(l1, h1), od, 0, 0, 0);
  od = __builtin_amdgcn_mfma_f32_32x32x16_bf16(pa2, PK(l2, h2), od, 0, 0, 0);
  od = __builtin_amdgcn_mfma_f32_32x32x16_bf16(pa3, PK(l3, h3), od, 0, 0, 0);
#undef PK
}
__device__ __forceinline__ void pv_d0(f32x16* o, int vb, bf16x8 pa0, bf16x8 pa1, bf16x8 pa2, bf16x8 pa3) {
  pv_one<0>(o[0], vb, pa0, pa1, pa2, pa3); pv_one<1>(o[1], vb, pa0, pa1, pa2, pa3); pv_one<2>(o[2], vb, pa0, pa1, pa2, pa3); pv_one<3>(o[3], vb, pa0, pa1, pa2, pa3);
}

__device__ __forceinline__ void attn_dense_body(const bf16* __restrict__ Qb, const bf16* __restrict__ Kh, const bf16* __restrict__ Vh,
                                                unsigned short* __restrict__ Zb, int seq, char* lds, bool dry = false) {
  using TQ = bf16;
  using St = Stage<bf16>; using SQ = Stage<TQ>;
  const int tid = otid(), wid = tid >> 6, lane = tid & 63, r32 = lane & 31, hi = lane >> 5;
  bf16* V_lds = (bf16*)lds; bf16* K_lds = (bf16*)(lds + 2 * SHM_V);
  float* ws = (float*)(lds + 2 * SHM_V + 2 * SHM_K) + wid * 64; float* li_l = ws; float* al_l = ws + 32;
  float m_reg = -1e30f, l_reg = 0; f32x16 o[4] = {}; bf16x8 qr[8];
  const TQ* Qw = Qb + (long)(wid * QBLK + r32) * LDQ + hi * 8;
#pragma unroll
  for (int d0 = 0; d0 < 8; ++d0) qr[d0] = SQ::tobf(SQ::ld8(Qw + d0 * 16));
  const int sr = tid >> 4, sc = (tid & 15) * 8, vst0 = v_st(sr, sc), vst1 = v_st(32 + sr, sc);
  const int vb0 = (int)(uintptr_t)V_lds + v_rd_base(lane);
  struct { typename St::T vs0, vs1, ks0, ks1; } sr_[SDEPTH];
#define SLOAD(i, k0) do { sr_[i].vs0 = St::ld8(&Vh[(long)((k0) + sr) * LDK + sc]); sr_[i].vs1 = St::ld8(&Vh[(long)((k0) + 32 + sr) * LDK + sc]); \
    sr_[i].ks0 = St::ld8(&Kh[(long)((k0) + sr) * LDK + sc]); sr_[i].ks1 = St::ld8(&Kh[(long)((k0) + 32 + sr) * LDK + sc]); } while (0)
#define SWRITE(b, i) do { *(bf16x8*)((char*)V_lds + (b) * SHM_V + vst0) = St::tobf(sr_[i].vs0);          \
    *(bf16x8*)((char*)V_lds + (b) * SHM_V + vst1) = St::tobf(sr_[i].vs1); int kc = sc * 2;               \
    *(bf16x8*)((char*)K_lds + (b) * SHM_K + KSWZ(sr, kc)) = St::tobf(sr_[i].ks0);                       \
    *(bf16x8*)((char*)K_lds + (b) * SHM_K + KSWZ(32 + sr, kc)) = St::tobf(sr_[i].ks1); } while (0)
#define SWAIT() do { if constexpr (SDEPTH == 2) asm volatile("s_waitcnt vmcnt(4)" ::: "memory"); else asm volatile("s_waitcnt vmcnt(0)" ::: "memory"); } while (0)
#define RESC(a) do { if (__any((a) < 1.f)) { if (hi == 0) al_l[r32] = (a); asm volatile("s_waitcnt lgkmcnt(0)" ::: "memory"); \
    for (int d = 0; d < 4; ++d) for (int r = 0; r < 16; ++r) o[d][r] *= al_l[crow(r, hi)]; } } while (0)
  f32x16 pA0, pA1, pB0, pB1; float mnA, mnB, alA, alB; bf16x8 pa0, pa1, pa2, pa3; const int NT = seq / KVBLK;
  constexpr int SE = 0, SO = SDEPTH - 1;
  SLOAD(SE, 0); asm volatile("s_waitcnt vmcnt(0)" ::: "memory"); SWRITE(0, SE); __syncthreads();
  qkt(pA0, pA1, K_lds, qr, r32, hi); partialSM(pA0, pA1, m_reg, mnA, alA);
  SLOAD(SO, KVBLK); if constexpr (SDEPTH == 2) { if (2 < NT) SLOAD(SE, 2 * KVBLK); }
  SWAIT(); SWRITE(1, SO); __syncthreads();
  for (int j = 1; j + 1 < NT; j += 2) {
    SBAR(); qkt(pB0, pB1, (bf16*)((char*)K_lds + SHM_K), qr, r32, hi);
    finishSM(pA0, pA1, alA, l_reg, pa0, pa1, pa2, pa3); SBAR();
    SLOAD(SO, (j + SDEPTH) * KVBLK); SBAR();
    pv_d0(o, vb0, pa0, pa1, pa2, pa3); partialSM(pB0, pB1, m_reg, mnB, alB);
    __syncthreads(); SWAIT(); SWRITE(0, SE);
    RESC(alB); __syncthreads();
    SBAR(); qkt(pA0, pA1, K_lds, qr, r32, hi);
    finishSM(pB0, pB1, alB, l_reg, pa0, pa1, pa2, pa3); SBAR();
    if (SDEPTH == 1 || j + 3 < NT) SLOAD(SE, (j + 1 + SDEPTH) * KVBLK); SBAR();
    pv_d0(o, vb0 + (int)SHM_V, pa0, pa1, pa2, pa3); partialSM(pA0, pA1, m_reg, mnA, alA);
    __syncthreads(); SWAIT(); SWRITE(1, SO);
    RESC(alA); __syncthreads();
  }
  SBAR(); qkt(pB0, pB1, (bf16*)((char*)K_lds + SHM_K), qr, r32, hi);
  finishSM(pA0, pA1, alA, l_reg, pa0, pa1, pa2, pa3); SBAR();
  pv_d0(o, vb0, pa0, pa1, pa2, pa3); partialSM(pB0, pB1, m_reg, mnB, alB);
  __syncthreads(); RESC(alB);
  finishSM(pB0, pB1, alB, l_reg, pa0, pa1, pa2, pa3); SBAR();
  pv_d0(o, vb0 + (int)SHM_V, pa0, pa1, pa2, pa3);
  if (hi == 0) li_l[r32] = l_reg; asm volatile("s_waitcnt lgkmcnt(0)" ::: "memory");
  float rli[16];
#pragma unroll
  for (int r = 0; r < 16; ++r) rli[r] = __builtin_amdgcn_rcpf(li_l[crow(r, hi)]);
  unsigned short* Zw = Zb + (long)(wid * QBLK) * LDZ;
#pragma unroll
  for (int r = 0; r < 16; ++r) { int orow = crow(r, hi);
#pragma unroll
    for (int d0 = 0; d0 < 4; ++d0) { unsigned short* zp = Zw + (long)orow * LDZ + d0 * 32 + r32;
      const float z = __uint_as_float(((unsigned)*zp) << 16); const float val = o[d0][r] * rli[r] * (z / (1.f + __expf(-z)));
      unsigned u = __float_as_uint(val); if (!dry) *zp = (unsigned short)((u + 0x7fffu + ((u >> 16) & 1u)) >> 16); } }
#undef SLOAD
#undef SWRITE
#undef SWAIT
#undef RESC
}
#undef KSWZ
#undef SBAR
}
namespace pg8 {
#define PG8_LAS __attribute__((address_space(3)))
typedef unsigned short bf16_t;
typedef short bf16x8 __attribute__((ext_vector_type(8)));
typedef float f32x4 __attribute__((ext_vector_type(4)));
typedef unsigned u32x4 __attribute__((ext_vector_type(4)));
constexpr int BM = 256, BK = 64, HALF = 128, HTB = HALF * BK * 2  , STAGE_BYTES = 8 * HTB, NXCD = 8, WGM = 4;

__host__ __device__ __forceinline__ int lds_byte(int r, int c) { const int st = (r >> 4) * 2 + (c >> 5), rr = r & 15, cc = c & 31, ob = rr * 64 + cc * 2; return st * 1024 + (ob ^ (((ob >> 9) & 1) << 5)); }
__host__ __device__ __forceinline__ void stage_rc(int b, int& R, int& C) { const int st = b / 1024, sb = b % 1024, swz = sb ^ (((sb >> 9) & 1) << 5); R = (st >> 1) * 16 + swz / 64; C = (st & 1) * 32 + (swz % 64) / 2; }
__host__ __device__ __forceinline__ int perm32(int rho) { const int n = rho >> 4, i = rho & 15; return 8 * (i >> 2) + 4 * n + (i & 3); }

struct Unit { int pm, pn; };
struct Gemm { const bf16_t* A; const bf16_t* Bt; int M, N, K; };

struct StaticOrder {
    int nM, nN, nwg, G, c;
    __host__ __device__ void init(int M, int N, int G_, int c_) { nM = M / BM; nN = N / BM; nwg = nM * nN; G = G_; c = c_; }
    __host__ __device__ bool next(int i, Unit& u) const {
        const long L = (long)i * G + c; if (L >= nwg) return false;
        int wgid = (int)L; { const int q = nwg / NXCD, r = nwg % NXCD, xcd = wgid % NXCD, off = wgid / NXCD; wgid = (xcd < r ? xcd * (q + 1) : r * (q + 1) + (xcd - r) * q) + off; }
        const int nig = WGM * nN, gid = wgid / nig, fm = gid * WGM, gsz = (nM - fm) < WGM ? (nM - fm) : WGM;
        u.pm = fm + ((wgid % nig) % gsz); u.pn = (wgid % nig) / gsz; return true;
    }
    __device__ __forceinline__ void a_ready(const Unit&) const {}
    __device__ __forceinline__ void done(const Unit&) const {}
};

__device__ __forceinline__ unsigned cvt_pk_bf16(float lo, float hi) { unsigned r; asm volatile("v_cvt_pk_bf16_f32 %0, %1, %2" : "=v"(r) : "v"(lo), "v"(hi)); return r; }
struct EpiP {
    static constexpr bool PERM = true, AFTER_DRAIN = false;
    unsigned char* P; int tg;
    __device__ __forceinline__ void operator()(const f32x4 (&acc)[2][2][4][2], const Unit& u, int wr, int wc, int fr, int fq) const {
        const SubInfo si = sub_info(u.pn * BM);
        bf16_t* base = (bf16_t*)(P + (size_t)si.col0 * tg * 2);
        const int lc = u.pn * BM - si.col0 + wc * 32 + 8 * fq, row0 = u.pm * BM + wr * 64 + fr;
        if (si.col0 == C_GLU) {
            const int vc = ((u.pn * BM - C_GLU) >> 8) * 128 + wc * 32 + 8 * fq;
#pragma unroll
            for (int ai = 0; ai < 2; ++ai)
#pragma unroll
                for (int m = 0; m < 4; ++m) { const f32x4 a0 = acc[ai][0][m][0], a1 = acc[ai][0][m][1], g0 = acc[ai][1][m][0], g1 = acc[ai][1][m][1];
                    u32x4 w; w.x = cvt_pk_bf16(a0[0] * sigm(g0[0]), a0[1] * sigm(g0[1])); w.y = cvt_pk_bf16(a0[2] * sigm(g0[2]), a0[3] * sigm(g0[3]));
                    w.z = cvt_pk_bf16(a1[0] * sigm(g1[0]), a1[1] * sigm(g1[1])); w.w = cvt_pk_bf16(a1[2] * sigm(g1[2]), a1[3] * sigm(g1[3]));
                    *(u32x4*)(base + (size_t)(row0 + ai * HALF + m * 16) * 512 + vc) = w; }
            return;
        }
#pragma unroll
        for (int ai = 0; ai < 2; ++ai)
#pragma unroll
            for (int m = 0; m < 4; ++m) { bf16_t* rowp = base + (size_t)(row0 + ai * HALF + m * 16) * si.width + lc;
#pragma unroll
                for (int bj = 0; bj < 2; ++bj) { const f32x4 v0 = acc[ai][bj][m][0], v1 = acc[ai][bj][m][1];
                    u32x4 w; w.x = cvt_pk_bf16(v0[0], v0[1]); w.y = cvt_pk_bf16(v0[2], v0[3]); w.z = cvt_pk_bf16(v1[0], v1[1]); w.w = cvt_pk_bf16(v1[2], v1[3]);
                    *(u32x4*)(rowp + bj * HALF) = w; } }
    }
};
struct BrOrder {
    int ntile, G, c, tpg;
    __device__ __forceinline__ bool next(int i, Unit& u) const {
        const int tile = c + (i >> 2) * G; if (tile >= ntile) return false;
        const int br = i & 3; u.pm = br * tpg + (tile >> 2); u.pn = br * 4 + (tile & 3); return true;
    }
    __device__ __forceinline__ void a_ready(const Unit&) const {}
    __device__ __forceinline__ void done(const Unit&) const {}
};
struct EpiBr {
    static constexpr bool PERM = true, AFTER_DRAIN = false;
    const bf16_t* MG; float* Macc; bf16_t* merged; int tpg;
    __device__ __forceinline__ void operator()(const f32x4 (&acc)[2][2][4][2], const Unit& u, int wr, int wc, int fr, int fq) const {
        const int br = u.pn >> 2, pn = u.pn & 3, pm = u.pm - br * tpg;
        const int row0 = pm * BM + wr * 64 + fr, col0 = pn * BM + wc * 32 + 8 * fq;
#pragma unroll
        for (int ai = 0; ai < 2; ++ai)
#pragma unroll
            for (int m = 0; m < 4; ++m) { const size_t row = (size_t)(row0 + ai * HALF + m * 16);
#pragma unroll
                for (int bj = 0; bj < 2; ++bj) { const int col = col0 + bj * HALF;
                    const u32x4 gw = *(const u32x4*)(MG + row * 4096 + br * 1024 + col);
                    f32x4 v0 = acc[ai][bj][m][0], v1 = acc[ai][bj][m][1];
                    v0[0] *= sigm(bf2f(gw.x & 0xffffu)); v0[1] *= sigm(bf2f(gw.x >> 16)); v0[2] *= sigm(bf2f(gw.y & 0xffffu)); v0[3] *= sigm(bf2f(gw.y >> 16));
                    v1[0] *= sigm(bf2f(gw.z & 0xffffu)); v1[1] *= sigm(bf2f(gw.z >> 16)); v1[2] *= sigm(bf2f(gw.w & 0xffffu)); v1[3] *= sigm(bf2f(gw.w >> 16));
                    bf16_t* mp = (bf16_t*)Macc + row * 1024 + col;
                    if (br > 0) { const u32x4 pw = *(const u32x4*)mp;
                        v0[0] += bf2f(pw.x & 0xffffu); v0[1] += bf2f(pw.x >> 16); v0[2] += bf2f(pw.y & 0xffffu); v0[3] += bf2f(pw.y >> 16);
                        v1[0] += bf2f(pw.z & 0xffffu); v1[1] += bf2f(pw.z >> 16); v1[2] += bf2f(pw.w & 0xffffu); v1[3] += bf2f(pw.w >> 16); }
                    { u32x4 w; w.x = cvt_pk_bf16(v0[0], v0[1]); w.y = cvt_pk_bf16(v0[2], v0[3]); w.z = cvt_pk_bf16(v1[0], v1[1]); w.w = cvt_pk_bf16(v1[2], v1[3]);
                        if (br < 3) *(u32x4*)mp = w; else
                        *(u32x4*)(merged + row * 1024 + col) = w; } } }
    }
};
struct BrOrder2 {
    int ntile, G, c, tpg; bool skipctx;
    __device__ __forceinline__ bool next(int i, Unit& u) const {
        const int L = i * G + c; if (L >= 4 * ntile) return false;
        const int br = L / ntile, t = L - br * ntile; int pm = t >> 2; if (skipctx) pm = (pm >> 3) * 9 + 1 + (pm & 7);
        u.pm = br * tpg + pm; u.pn = br * 4 + (t & 3); return true;
    }
    __device__ __forceinline__ void a_ready(const Unit&) const {}
    __device__ __forceinline__ void done(const Unit&) const {}
};
struct EpiBr2 {
    static constexpr bool PERM = true, AFTER_DRAIN = false;
    const bf16_t* MG; bf16_t* Gb; int tpg; size_t gstride;
    __device__ __forceinline__ void operator()(const f32x4 (&acc)[2][2][4][2], const Unit& u, int wr, int wc, int fr, int fq) const {
        const int br = u.pn >> 2, pn = u.pn & 3, pm = u.pm - br * tpg;
        const int row0 = pm * BM + wr * 64 + fr, col0 = pn * BM + wc * 32 + 8 * fq;
        bf16_t* Go = Gb + (size_t)br * gstride;
#pragma unroll
        for (int ai = 0; ai < 2; ++ai)
#pragma unroll
            for (int m = 0; m < 4; ++m) { const size_t row = (size_t)(row0 + ai * HALF + m * 16);
                u32x4 gw[2];
#pragma unroll
                for (int bj = 0; bj < 2; ++bj) gw[bj] = *(const u32x4*)(MG + row * 4096 + br * 1024 + col0 + bj * HALF);
#pragma unroll
                for (int bj = 0; bj < 2; ++bj) { const int col = col0 + bj * HALF;
                    f32x4 v0 = acc[ai][bj][m][0], v1 = acc[ai][bj][m][1];
                    v0[0] *= sigm(bf2f(gw[bj].x & 0xffffu)); v0[1] *= sigm(bf2f(gw[bj].x >> 16)); v0[2] *= sigm(bf2f(gw[bj].y & 0xffffu)); v0[3] *= sigm(bf2f(gw[bj].y >> 16));
                    v1[0] *= sigm(bf2f(gw[bj].z & 0xffffu)); v1[1] *= sigm(bf2f(gw[bj].z >> 16)); v1[2] *= sigm(bf2f(gw[bj].w & 0xffffu)); v1[3] *= sigm(bf2f(gw[bj].w >> 16));
                    u32x4 w; w.x = cvt_pk_bf16(v0[0], v0[1]); w.y = cvt_pk_bf16(v0[2], v0[3]); w.z = cvt_pk_bf16(v1[0], v1[1]); w.w = cvt_pk_bf16(v1[2], v1[3]);
                    *(u32x4*)(Go + row * 1024 + col) = w; } }
    }
};
struct EpiOut {
    static constexpr bool PERM = true, AFTER_DRAIN = false;
    Params p; float* hpre; int l, g;
    __device__ __forceinline__ void operator()(const f32x4 (&acc)[2][2][4][2], const Unit& u, int wr, int wc, int fr, int fq) const {
        const int row0 = u.pm * BM + wr * 64 + fr, col0 = u.pn * BM + wc * 32 + 8 * fq;
        const float* mod = (const float*)(p.ws + WS_MOD);
#pragma unroll
        for (int ai = 0; ai < 2; ++ai)
#pragma unroll
            for (int m = 0; m < 4; ++m) { const int row = row0 + ai * HALF + m * 16, grow = g * p.tg + row, b = grow / TPB, s = grow % TPB;
                const float* hr = h_in_row(p, l, grow); const float* gt = mod + ((size_t)l * 9 + (s < CTX ? 8 : b)) * 3072 + 2048;
#pragma unroll
                for (int bj = 0; bj < 2; ++bj) { const int col = col0 + bj * HALF;
                    const f32x4 h0 = *(const f32x4*)(hr + col), h1 = *(const f32x4*)(hr + col + 4), g0 = *(const f32x4*)(gt + col), g1 = *(const f32x4*)(gt + col + 4);
                    float* op = hpre + (size_t)row * 1024 + col;
                    *(f32x4*)op = h0 * ALPHA + g0 * acc[ai][bj][m][0]; *(f32x4*)(op + 4) = h1 * ALPHA + g1 * acc[ai][bj][m][1]; } }
    }
};
template <class Epi, class Sched, bool ALIGN_EPI = false, bool SP2 = false>
__device__ __forceinline__ void gemm_phase(PG8_LAS unsigned char* lds, const Gemm g, const Sched& S, const Epi& E) {
    const int tid = otid(), wid = __builtin_amdgcn_readfirstlane(tid >> 6), lane = tid & 63, wr = wid >> 2, wc = wid & 3, fr = lane & 15, fq = lane >> 4;
    const int K = g.K, nt = K / BK;
    unsigned voffA[2], voffB[2];
#pragma unroll
    for (int i = 0; i < 2; ++i) { int R, C; stage_rc(tid * 16 + i * 8192, R, C); const int Rb = Epi::PERM ? ((R & ~31) + perm32(R & 31)) : R;
        voffA[i] = (unsigned)(R * K + C) * 2u; voffB[i] = (unsigned)(Rb * K + C) * 2u; }
    const size_t kstep = (size_t)(BK * 2);
    const size_t hstep = (size_t)HALF * K * 2;
    const size_t tstep = 2 * hstep;
    const unsigned ldsw = (unsigned)wid * 1024u;
    const int aoff = lds_byte(wr * 64 + fr, fq * 8), boff = lds_byte(wc * 32 + fr, fq * 8);
#define PG8_SA(b, h) (((b) * 2 + (h)) * HTB)
#define PG8_SB(b, h) ((4 + (b) * 2 + (h)) * HTB)
#define PG8_STAGE(bufoff, gbase, voff) do { _Pragma("unroll") for (int _i = 0; _i < 2; ++_i) \
        __builtin_amdgcn_global_load_lds((const unsigned*)((const char*)(gbase) + (voff)[_i]), (PG8_LAS unsigned*)(lds + (bufoff) + ldsw + _i * 8192), 16, 0, 0); } while (0)
#define PG8_LDA(dst, b, h) do { _Pragma("unroll") for (int m = 0; m < 4; ++m) _Pragma("unroll") for (int k = 0; k < 2; ++k) dst[m][k] = *(const PG8_LAS bf16x8*)(lds + PG8_SA(b, h) + aoff + m * 2048 + k * 1024); } while (0)
#define PG8_LDB(dst, b, h) do { _Pragma("unroll") for (int n = 0; n < 2; ++n) _Pragma("unroll") for (int k = 0; k < 2; ++k) dst[n][k] = *(const PG8_LAS bf16x8*)(lds + PG8_SB(b, h) + boff + n * 2048 + k * 1024); } while (0)
#define PG8_MMA(ai, bj, At, Bt) do { __builtin_amdgcn_s_setprio(1); _Pragma("unroll") for (int m = 0; m < 4; ++m) _Pragma("unroll") for (int n = 0; n < 2; ++n) _Pragma("unroll") for (int k = 0; k < 2; ++k) \
        acc[ai][bj][m][n] = __builtin_amdgcn_mfma_f32_16x16x32_bf16(Bt[n][k], At[m][k], acc[ai][bj][m][n], 0, 0, 0); __builtin_amdgcn_s_setprio(0); } while (0)
#define PG8_WAIT_V(n) asm volatile("s_waitcnt vmcnt(" #n ")" ::: "memory")
#define PG8_WAIT_L(n) asm volatile("s_waitcnt lgkmcnt(" #n ")" ::: "memory")
#define PG8_BAR __builtin_amdgcn_s_barrier()
#define PG8_SCHED __builtin_amdgcn_sched_barrier(0)
    Unit cur, nxt; int ui = 0;
    if (!S.next(0, cur)) return;
    f32x4 acc[2][2][4][2];
#pragma unroll
    for (int a = 0; a < 2; ++a)
#pragma unroll
        for (int b = 0; b < 2; ++b)
#pragma unroll
            for (int m = 0; m < 4; ++m)
#pragma unroll
                for (int n = 0; n < 2; ++n) acc[a][b][m][n] = (f32x4){0.f, 0.f, 0.f, 0.f};
    bf16x8 At[4][2], B0[2][2], B1[2][2];
    const char* cA = (const char*)g.A + (size_t)cur.pm * tstep; const char* cB = (const char*)g.Bt + (size_t)cur.pn * tstep;
    S.a_ready(cur);
    if constexpr (SP2) {
        PG8_STAGE(PG8_SB(0, 0), cB, voffB); PG8_STAGE(PG8_SB(0, 1), cB + hstep, voffB); PG8_STAGE(PG8_SA(0, 0), cA, voffA); PG8_STAGE(PG8_SA(0, 1), cA + hstep, voffA);
        if (wr == 1) PG8_BAR;
        PG8_WAIT_V(2); PG8_BAR;
        PG8_STAGE(PG8_SB(1, 0), cB + kstep, voffB); PG8_STAGE(PG8_SA(1, 0), cA + kstep, voffA); PG8_STAGE(PG8_SB(1, 1), cB + hstep + kstep, voffB);
        PG8_WAIT_V(6); PG8_BAR;
    } else {
        PG8_STAGE(PG8_SB(0, 0), cB, voffB); PG8_STAGE(PG8_SA(0, 0), cA, voffA); PG8_STAGE(PG8_SB(0, 1), cB + hstep, voffB); PG8_STAGE(PG8_SA(0, 1), cA + hstep, voffA);
        if (wr == 1) PG8_BAR;
        PG8_WAIT_V(4); PG8_BAR;
        PG8_STAGE(PG8_SB(1, 0), cB + kstep, voffB); PG8_STAGE(PG8_SA(1, 0), cA + kstep, voffA); PG8_STAGE(PG8_SB(1, 1), cB + hstep + kstep, voffB);
        PG8_WAIT_V(6); PG8_BAR;
    }
    for (;;) {
        const bool has_next = S.next(ui + 1, nxt);
        const char* nA = has_next ? (const char*)g.A + (size_t)nxt.pm * tstep : cA; const char* nB = has_next ? (const char*)g.Bt + (size_t)nxt.pn * tstep : cB;
        for (int t = 0; t < nt; t += 2) {
            const bool last = (t == nt - 2);
            const char* a1 = cA + (size_t)(t + 1) * kstep;
            const char* a2 = last ? nA : cA + (size_t)(t + 2) * kstep; const char* b2 = last ? nB : cB + (size_t)(t + 2) * kstep;
            const char* a3 = a2 + kstep; const char* b3 = b2 + kstep;
            if (last && has_next) S.a_ready(nxt);
            if constexpr (SP2) {
            PG8_LDB(B0, 0, 0); PG8_LDB(B1, 0, 1); PG8_SCHED; PG8_LDA(At, 0, 0); PG8_STAGE(PG8_SA(1, 1), a1 + hstep, voffA);
            PG8_WAIT_V(8); PG8_WAIT_L(0); PG8_BAR; PG8_MMA(0, 0, At, B0); PG8_MMA(0, 1, At, B1); PG8_BAR; PG8_SCHED;
            PG8_LDA(At, 0, 1); PG8_STAGE(PG8_SB(0, 0), b2, voffB); PG8_STAGE(PG8_SB(0, 1), b2 + hstep, voffB); PG8_STAGE(PG8_SA(0, 0), a2, voffA);
            PG8_WAIT_V(8); PG8_WAIT_L(0); PG8_BAR; PG8_MMA(1, 0, At, B0); PG8_MMA(1, 1, At, B1); PG8_BAR; PG8_SCHED;
            PG8_LDB(B0, 1, 0); PG8_LDB(B1, 1, 1); PG8_SCHED; PG8_LDA(At, 1, 0); PG8_STAGE(PG8_SA(0, 1), a2 + hstep, voffA);
            PG8_WAIT_V(8); PG8_WAIT_L(0); PG8_BAR; PG8_MMA(0, 0, At, B0); PG8_MMA(0, 1, At, B1); PG8_BAR; PG8_SCHED;
            PG8_LDA(At, 1, 1); PG8_STAGE(PG8_SB(1, 0), b3, voffB); PG8_STAGE(PG8_SB(1, 1), b3 + hstep, voffB); PG8_STAGE(PG8_SA(1, 0), a3, voffA);
            PG8_WAIT_V(8); PG8_WAIT_L(0); PG8_BAR; PG8_MMA(1, 0, At, B0); PG8_MMA(1, 1, At, B1); PG8_BAR; PG8_SCHED;
            } else {
            PG8_LDB(B0, 0, 0); PG8_SCHED; PG8_LDA(At, 0, 0); PG8_STAGE(PG8_SA(1, 1), a1 + hstep, voffA);
            PG8_WAIT_L(8); PG8_BAR; PG8_WAIT_L(0); PG8_MMA(0, 0, At, B0); PG8_BAR; PG8_SCHED;
            PG8_LDB(B1, 0, 1); PG8_STAGE(PG8_SB(0, 0), b2, voffB);
            PG8_BAR; PG8_WAIT_L(0); PG8_MMA(0, 1, At, B1); PG8_BAR;
            PG8_LDA(At, 0, 1); PG8_STAGE(PG8_SA(0, 0), a2, voffA);
            PG8_BAR; PG8_WAIT_L(0); PG8_MMA(1, 0, At, B0); PG8_BAR; PG8_SCHED;
            PG8_STAGE(PG8_SB(0, 1), b2 + hstep, voffB);
            PG8_WAIT_V(6); PG8_BAR; PG8_MMA(1, 1, At, B1); PG8_BAR;
            PG8_LDB(B0, 1, 0); PG8_SCHED; PG8_LDA(At, 1, 0); PG8_STAGE(PG8_SA(0, 1), a2 + hstep, voffA);
            PG8_WAIT_L(8); PG8_BAR; PG8_WAIT_L(0); PG8_MMA(0, 0, At, B0); PG8_BAR; PG8_SCHED;
            PG8_LDB(B1, 1, 1); PG8_STAGE(PG8_SB(1, 0), b3, voffB);
            PG8_BAR; PG8_WAIT_L(0); PG8_MMA(0, 1, At, B1); PG8_BAR;
            PG8_LDA(At, 1, 1); PG8_STAGE(PG8_SA(1, 0), a3, voffA);
            PG8_BAR; PG8_WAIT_L(0); PG8_MMA(1, 0, At, B0); PG8_BAR; PG8_SCHED;
            PG8_STAGE(PG8_SB(1, 1), b3 + hstep, voffB);
            PG8_WAIT_V(6); PG8_BAR; PG8_MMA(1, 1, At, B1); PG8_BAR;
            }
        }
        if constexpr (ALIGN_EPI) { if (wr == 0) PG8_BAR; }
        if constexpr (!Epi::AFTER_DRAIN) { E(acc, cur, wr, wc, fr, fq); S.done(cur); }
        if (!has_next) break;
#pragma unroll
        for (int a = 0; a < 2; ++a)
#pragma unroll
            for (int b = 0; b < 2; ++b)
#pragma unroll
                for (int m = 0; m < 4; ++m)
#pragma unroll
                    for (int n = 0; n < 2; ++n) acc[a][b][m][n] = (f32x4){0.f, 0.f, 0.f, 0.f};
        cur = nxt; cA = nA; cB = nB; ++ui;
        if constexpr (ALIGN_EPI) { if (wr == 1) PG8_BAR; }
    }
    PG8_WAIT_V(0);
    if constexpr (!ALIGN_EPI) { if (wr == 0) PG8_BAR; }
    PG8_BAR;
    if constexpr (Epi::AFTER_DRAIN) { E.fused(acc, cur, wr, wc, fr, fq, lds, wid, lane); S.done(cur); }
#undef PG8_SA
#undef PG8_SB
#undef PG8_STAGE
#undef PG8_LDA
#undef PG8_LDB
#undef PG8_MMA
#undef PG8_WAIT_V
#undef PG8_WAIT_L
#undef PG8_BAR
#undef PG8_SCHED
}
}
__device__ __forceinline__ void mod_item(const Params& p, int item, unsigned char* lds) {
    const int l = item / 48, cb = item % 48, t = otid(), lane = t & 63, w = t >> 6;
    float* sc = (float*)lds; float* red = sc + 9 * 1024;
    for (int i = t; i < 9 * 1024; i += 512) { const int b = i >> 10, k = i & 1023; const float v = b < 8 ? p.c[b * 1024 + k] : p.c_ctx[k]; sc[i] = silu(v); }
    __syncthreads();
    const float* wm = p.w_mod + (size_t)l * 1024 * 3072 + cb * 64 + lane;
    float acc[9];
#pragma unroll
    for (int b = 0; b < 9; ++b) acc[b] = 0.f;
#pragma unroll 16
    for (int k = w * 128; k < w * 128 + 128; ++k) { const float wv = wm[(size_t)k * 3072];
#pragma unroll
        for (int b = 0; b < 9; ++b) acc[b] += sc[b * 1024 + k] * wv; }
#pragma unroll
    for (int b = 0; b < 9; ++b) red[(w * 9 + b) * 64 + lane] = acc[b];
    __syncthreads();
    float* mod = (float*)(p.ws + WS_MOD);
    for (int i = t; i < 576; i += 512) { const int b = i >> 6, c = i & 63; float s = 0.f;
#pragma unroll
        for (int w2 = 0; w2 < 8; ++w2) s += red[(w2 * 9 + b) * 64 + c];
        mod[((size_t)l * 9 + b) * 3072 + cb * 64 + c] = s + p.b_mod[l * 3072 + cb * 64 + c]; }
    __syncthreads();
}
struct TJob { const float* src; bf16_t* dst; int spitch, dpitch, nvalid; };
__device__ __forceinline__ TJob tjob(const Params& p, int it) {
    constexpr int N_WIN = 2 * 168 * 16, N_R = 32, N_BR = 1024;
    bf16_t* Win_t = (bf16_t*)(p.ws + WS_WIN); bf16_t* Wr_t = (bf16_t*)(p.ws + WS_WR); bf16_t* Wbr_t = (bf16_t*)(p.ws + WS_WBR); bf16_t* Wout_t = (bf16_t*)(p.ws + WS_WOUT);
    TJob j;
    if (it < N_WIN) { const int l = it / 2688, rem = it % 2688, nt = rem / 16, kt = rem % 16, n0 = nt * 64; const SubInfo si = sub_info(n0);
        int oc = si.orig0 + (n0 - si.col0);
        if (si.col0 == C_GLU) { const int jj = n0 - C_GLU; oc = si.orig0 + ((jj & 255) >> 7) * 512 + (jj >> 8) * 128 + (jj & 127); }
        j.src = p.w_in + (size_t)l * 1024 * WIN_COLS + (size_t)(kt * 64) * WIN_COLS + oc; j.spitch = WIN_COLS; j.nvalid = 64;
        j.dst = Win_t + (size_t)l * NCOL * 1024 + (size_t)n0 * 1024 + kt * 64; j.dpitch = 1024; return j; }
    it -= N_WIN;
    if (it < N_R) { const int l = it / 16, kt = it % 16;
        j.src = p.w_in + (size_t)l * 1024 * WIN_COLS + (size_t)(kt * 64) * WIN_COLS + 5120; j.spitch = WIN_COLS; j.nvalid = 32; j.dst = Wr_t + (size_t)l * 32 * 1024 + kt * 64; j.dpitch = 1024; return j; }
    it -= N_R;
    if (it < N_BR) { const int li = it / 128, rem = it % 128, kt = rem / 16, nt = rem % 16;
        j.src = p.w_br + ((size_t)li * 512 + kt * 64) * 1024 + nt * 64; j.spitch = 1024; j.nvalid = 64; j.dst = Wbr_t + ((size_t)li * 1024 + nt * 64) * 512 + kt * 64; j.dpitch = 512; return j; }
    it -= N_BR;
    { const int l = it / 256, rem = it % 256, kt = rem / 16, nt = rem % 16;
        j.src = p.w_out + ((size_t)l * 1024 + kt * 64) * 1024 + nt * 64; j.spitch = 1024; j.nvalid = 64; j.dst = Wout_t + ((size_t)l * 1024 + nt * 64) * 1024 + kt * 64; j.dpitch = 1024; return j; }
}
__device__ __forceinline__ void phase0(const Params& p, unsigned char* lds) {
    constexpr int N_T = 2 * 168 * 16 + 32 + 1024 + 512, N_MOD = 96;
    const int G = gridDim.x, bid = blockIdx.x;
    if (bid >= G - N_MOD || G < N_MOD) { for (int it = (G < N_MOD ? bid : bid - (G - N_MOD)); it < N_MOD; it += (G < N_MOD ? G : N_MOD)) mod_item(p, it, lds); }
    float* tile = (float*)lds;
    const int t = otid(), r = t >> 3, c8 = (t & 7) * 8;
    int it = bid, buf = 0;
    f32x4 a = {0.f, 0.f, 0.f, 0.f}, b = {0.f, 0.f, 0.f, 0.f};
    TJob cur = tjob(p, it < N_T ? it : 0);
    if (it < N_T && c8 < cur.nvalid) { a = *(const f32x4*)(cur.src + (size_t)r * cur.spitch + c8); b = *(const f32x4*)(cur.src + (size_t)r * cur.spitch + c8 + 4); }
    for (; it < N_T; it += G) {
        const int nit = it + G; f32x4 na = {0.f, 0.f, 0.f, 0.f}, nb = {0.f, 0.f, 0.f, 0.f};
        TJob nxt = tjob(p, nit < N_T ? nit : 0);
        if (nit < N_T && c8 < nxt.nvalid) { na = *(const f32x4*)(nxt.src + (size_t)r * nxt.spitch + c8); nb = *(const f32x4*)(nxt.src + (size_t)r * nxt.spitch + c8 + 4); }
        float* tb = tile + buf * (64 * 65);
        { float* tp = tb + r * 65 + c8; tp[0] = a[0]; tp[1] = a[1]; tp[2] = a[2]; tp[3] = a[3]; tp[4] = b[0]; tp[5] = b[1]; tp[6] = b[2]; tp[7] = b[3]; }
        __syncthreads();
        if (r < cur.nvalid) { u32x4 w;
            w.x = pk2(tb[(c8 + 0) * 65 + r], tb[(c8 + 1) * 65 + r]); w.y = pk2(tb[(c8 + 2) * 65 + r], tb[(c8 + 3) * 65 + r]);
            w.z = pk2(tb[(c8 + 4) * 65 + r], tb[(c8 + 5) * 65 + r]); w.w = pk2(tb[(c8 + 6) * 65 + r], tb[(c8 + 7) * 65 + r]);
            *(u32x4*)(cur.dst + (size_t)r * cur.dpitch + c8) = w; }
        cur = nxt; a = na; b = nb; buf ^= 1;
    }
    __syncthreads();
}

__device__ __forceinline__ void ln_phase(const Params& p, int mode, int l, int lu, int row0, int nrows, const float* __restrict__ hpre) {
    const int tid_ = otid(), lane = tid_ & 63, w = tid_ >> 6;
    const float* mod = (const float*)(p.ws + WS_MOD); bf16_t* U = (bf16_t*)(p.ws + WS_U); float* hctx = (float*)(p.ws + WS_HCTX);
    const int neff = mode == 2 ? (nrows / TPB) * SEQ : nrows, stride = gridDim.x * 8;
#define LN_ROW(i) (mode == 2 ? ((i) / SEQ) * TPB + CTX + (i) % SEQ : (i))
#define LN_SRC(rr) (mode == 0 ? h_in_row(p, 0, row0 + (rr)) : hpre + (size_t)(rr) * 1024)
    int ie = blockIdx.x * 8 + w;
    f32x4 nv[4];
#pragma unroll
    for (int q = 0; q < 4; ++q) nv[q] = (f32x4){0.f, 0.f, 0.f, 0.f};
    if (ie < neff) { const float* src = LN_SRC(LN_ROW(ie));
#pragma unroll
        for (int q = 0; q < 4; ++q) nv[q] = *(const f32x4*)(src + q * 256 + lane * 4); }
    for (; ie < neff; ie += stride) {
        const int rr = LN_ROW(ie), grow = row0 + rr, b = grow / TPB, s = grow % TPB; const bool isctx = s < CTX;
        f32x4 v[4];
#pragma unroll
        for (int q = 0; q < 4; ++q) v[q] = nv[q];
        if (ie + stride < neff) { const float* src = LN_SRC(LN_ROW(ie + stride));
#pragma unroll
            for (int q = 0; q < 4; ++q) nv[q] = *(const f32x4*)(src + q * 256 + lane * 4); }
        float s1 = 0.f;
#pragma unroll
        for (int q = 0; q < 4; ++q) s1 += (v[q][0] + v[q][1]) + (v[q][2] + v[q][3]);
        float mean = wave_sum(s1) * (1.f / 1024.f), s2 = 0.f;
#pragma unroll
        for (int q = 0; q < 4; ++q) { const f32x4 d = v[q] - mean; s2 += (d[0] * d[0] + d[1] * d[1]) + (d[2] * d[2] + d[3] * d[3]); }
        float rstd = rsqrtf(wave_sum(s2) * (1.f / 1024.f) + EPS);
        if (mode != 0) {
            float* hdst = isctx ? hctx + ((size_t)b * CTX + s) * 1024 : p.out + ((size_t)b * SEQ + (s - CTX)) * 1024;
#pragma unroll
            for (int q = 0; q < 4; ++q) { const int col = q * 256 + lane * 4;
                const f32x4 gg = *(const f32x4*)(p.ln_g + l * 1024 + col), bb = *(const f32x4*)(p.ln_b + l * 1024 + col);
                v[q] = (v[q] - mean) * rstd * gg + bb; *(f32x4*)(hdst + col) = v[q]; }
            if (mode == 2) continue;
            s1 = 0.f;
#pragma unroll
            for (int q = 0; q < 4; ++q) s1 += (v[q][0] + v[q][1]) + (v[q][2] + v[q][3]);
            mean = wave_sum(s1) * (1.f / 1024.f); s2 = 0.f;
#pragma unroll
            for (int q = 0; q < 4; ++q) { const f32x4 d = v[q] - mean; s2 += (d[0] * d[0] + d[1] * d[1]) + (d[2] * d[2] + d[3] * d[3]); }
            rstd = rsqrtf(wave_sum(s2) * (1.f / 1024.f) + EPS);
        }
        const float* md = mod + ((size_t)lu * 9 + (isctx ? 8 : b)) * 3072;
#pragma unroll
        for (int q = 0; q < 4; ++q) { const int col = q * 256 + lane * 4;
            const f32x4 sh = *(const f32x4*)(md + col), scl = *(const f32x4*)(md + 1024 + col);
            const f32x4 uu = (v[q] - mean) * rstd * (scl + 1.f) + sh;
            uint2 o; o.x = pk2(uu[0], uu[1]); o.y = pk2(uu[2], uu[3]);
            *(uint2*)(U + (size_t)grow * 1024 + col) = o; }
    }
#undef LN_ROW
#undef LN_SRC
}

__device__ __forceinline__ void r_items(const Params& p, int l, int g, unsigned char* lds) {
    const int tid_ = otid(), lane = tid_ & 63, w = tid_ >> 6, fr = lane & 15, fq = lane >> 4, tg = p.tg, nit = tg / 16;
    if ((int)blockIdx.x * 8 >= nit) return;
    const bf16_t* U = (const bf16_t*)(p.ws + WS_U) + (size_t)g * tg * 1024; float* R = (float*)(p.ws + WS_R) + (size_t)g * tg * 32;
    const bf16_t* W = (const bf16_t*)(p.ws + WS_WR) + (size_t)l * 32 * 1024;
    bf16_t* wl = (bf16_t*)lds;
    for (int i = tid_; i < 4096; i += 512) { const int n = i >> 7, k8 = (i & 127) * 8; *(u32x4*)(wl + n * 1032 + k8) = *(const u32x4*)(W + (size_t)n * 1024 + k8); }
    __syncthreads();
    for (int it = blockIdx.x * 8 + w; it < nit; it += gridDim.x * 8) {
        f32x4 a0 = {0.f, 0.f, 0.f, 0.f}, a1 = {0.f, 0.f, 0.f, 0.f};
        const bf16_t* up = U + (size_t)(it * 16 + fr) * 1024 + fq * 8;
#pragma unroll 1
        for (int kh = 0; kh < 2; ++kh) {
            bf16x8 av[16];
#pragma unroll
            for (int ks = 0; ks < 16; ++ks) av[ks] = *(const bf16x8*)(up + (kh * 16 + ks) * 32);
#pragma unroll
            for (int ks = 0; ks < 16; ++ks) { const int ko = (kh * 16 + ks) * 32 + fq * 8;
                const bf16x8 b0 = *(const bf16x8*)(wl + fr * 1032 + ko), b1 = *(const bf16x8*)(wl + (16 + fr) * 1032 + ko);
                a0 = __builtin_amdgcn_mfma_f32_16x16x32_bf16(av[ks], b0, a0, 0, 0, 0); a1 = __builtin_amdgcn_mfma_f32_16x16x32_bf16(av[ks], b1, a1, 0, 0, 0); }
        }
#pragma unroll
        for (int jj = 0; jj < 4; ++jj) { float* rp = R + (size_t)(it * 16 + fq * 4 + jj) * 32; rp[fr] = a0[jj]; rp[16 + fr] = a1[jj]; }
    }
    __syncthreads();
}
__device__ __forceinline__ void qk_prep(const Params& p, int l, bool dry = false) {
    const int tid_ = otid(), lane = tid_ & 63, w = tid_ >> 6, tg = p.tg;
    bf16_t* Aq = subbuf(p, C_AQ); bf16_t* Ak = subbuf(p, C_AK);
    const float qg0 = p.q_norm[l * 128 + 2 * lane], qg1 = p.q_norm[l * 128 + 2 * lane + 1], kg0 = p.k_norm[l * 128 + 2 * lane], kg1 = p.k_norm[l * 128 + 2 * lane + 1];
    const float inv = exp2f(-(float)(lane & 31) * (13.287712379549449f / 32.f)) * 0.15915494309189535f;
    for (int row = blockIdx.x * 8 + w; row < tg; row += gridDim.x * 8) {
        const int s = row % TPB; float cs = 1.f, sn = 0.f;
        if (s >= CTX) { const int t = s - CTX; const int pos = lane < 32 ? (t >> 6) : (t & 63); float rev = (float)pos * inv; rev -= floorf(rev);
            sn = __builtin_amdgcn_sinf(rev); cs = __builtin_amdgcn_cosf(rev); }
        unsigned pr[6];
#pragma unroll
        for (int hh = 0; hh < 6; ++hh) { const bf16_t* ptr = hh < 4 ? Aq + (size_t)row * 512 + hh * 128 + 2 * lane : Ak + (size_t)row * 256 + (hh - 4) * 128 + 2 * lane; pr[hh] = *(const unsigned*)ptr; }
#pragma unroll
        for (int hh = 0; hh < 6; ++hh) {
            bf16_t* ptr = hh < 4 ? Aq + (size_t)row * 512 + hh * 128 + 2 * lane : Ak + (size_t)row * 256 + (hh - 4) * 128 + 2 * lane;
            const float x0 = bf2f(pr[hh] & 0xffffu), x1 = bf2f(pr[hh] >> 16);
            const float ss = wave_sum(x0 * x0 + x1 * x1), rinv = rsqrtf(ss * (1.f / 128.f) + EPS);
            const float y0 = x0 * rinv * (hh < 4 ? qg0 : kg0), y1 = x1 * rinv * (hh < 4 ? qg1 : kg1);
            if (!dry) *(unsigned*)ptr = pk2(y0 * cs - y1 * sn, y0 * sn + y1 * cs);
        }
    }
}
__device__ __forceinline__ void short_conv(const Params& p, int l, bool dry = false) {
    const int tg = p.tg; const bf16_t* Bg = subbuf(p, C_BG); const bf16_t* Cg = subbuf(p, C_CG); const bf16_t* Xin = subbuf(p, C_XIN); bf16_t* Zb = subbuf(p, C_ZB);
    const float* wv = p.b_conv + l * 3 * 512;
    const int tid_ = otid();
    for (int idx = blockIdx.x * 512 + tid_; idx < tg * 64; idx += gridDim.x * 512) {
        const int row = idx >> 6, c8 = (idx & 63) * 8, s = row % TPB; const size_t o = (size_t)row * 512 + c8;
        const bool hp = (s != 0 && s != CTX), hn = (s != CTX - 1 && s != TPB - 1);
        const u32x4 zero = {0u, 0u, 0u, 0u};
        const u32x4 bg = *(const u32x4*)(Bg + o), zb = *(const u32x4*)(Zb + o), c1 = *(const u32x4*)(Cg + o), x1 = *(const u32x4*)(Xin + o);
        const u32x4 c0 = hp ? *(const u32x4*)(Cg + o - 512) : zero, x0 = hp ? *(const u32x4*)(Xin + o - 512) : zero;
        const u32x4 c2 = hn ? *(const u32x4*)(Cg + o + 512) : zero, x2 = hn ? *(const u32x4*)(Xin + o + 512) : zero;
        u32x4 ow;
#pragma unroll
        for (int e = 0; e < 4; ++e) {
            float res[2];
#pragma unroll
            for (int hl = 0; hl < 2; ++hl) { const int c = c8 + 2 * e + hl; const int sh = hl * 16;
                const float p0 = bf2f((c0[e] >> sh) & 0xffffu) * bf2f((x0[e] >> sh) & 0xffffu), p1 = bf2f((c1[e] >> sh) & 0xffffu) * bf2f((x1[e] >> sh) & 0xffffu),
                            p2 = bf2f((c2[e] >> sh) & 0xffffu) * bf2f((x2[e] >> sh) & 0xffffu);
                const float cv = wv[c] * p0 + wv[512 + c] * p1 + wv[1024 + c] * p2;
                res[hl] = bf2f((bg[e] >> sh) & 0xffffu) * cv * silu(bf2f((zb[e] >> sh) & 0xffffu)); }
            ow[e] = pk2(res[0], res[1]);
        }
        if (!dry) *(u32x4*)(Zb + o) = ow;
    }
}
__device__ __forceinline__ void conformer(const Params& p, int l, unsigned char* lds, bool dry = false, bool skipctx = false) {
    const int tg = p.tg, c = otid(), lane = c & 63, w = c >> 6;
    float* hbuf = (float*)lds;
    bf16_t* vt = (bf16_t*)(lds + 32768);
    const bf16_t* Glu = subbuf(p, C_GLU); bf16_t* Zd = subbuf(p, C_ZD);
    float wk[31];
#pragma unroll
    for (int k = 0; k < 31; ++k) wk[k] = p.d_conv_w[((size_t)l * 31 + k) * 512 + c];
    const float bias = p.d_conv_b[l * 512 + c];
    const int nit = skipctx ? (tg / TPB) * (SEQ / 16) : tg / 16;
    for (int it_ = blockIdx.x; it_ < nit; it_ += gridDim.x) {
        const int it = skipctx ? (it_ >> 7) * 144 + 16 + (it_ & 127) : it_;
        const int r0 = it * 16, s0 = r0 % TPB, bstart = r0 - s0;
        const int seg_lo = s0 < CTX ? bstart : bstart + CTX, seg_hi = s0 < CTX ? bstart + CTX : bstart + TPB;
#pragma unroll
        for (int k6 = 0; k6 < 6; ++k6) { const int idx = c + k6 * 512;
            if (idx < 46 * 64) { const int r = idx >> 6, c8 = (idx & 63) * 8, row = r0 - 15 + r; u32x4 val = {0u, 0u, 0u, 0u};
                if (row >= seg_lo && row < seg_hi) val = *(const u32x4*)(Glu + (size_t)row * 512 + c8);
                *(u32x4*)(vt + r * 512 + c8) = val; } }
        __syncthreads();
        float v[46];
#pragma unroll
        for (int i = 0; i < 46; ++i) v[i] = bf2f(vt[i * 512 + c]);
#pragma unroll
        for (int t = 0; t < 16; ++t) { float hh = bias;
#pragma unroll
            for (int k = 0; k < 31; ++k) hh += wk[k] * v[t + k];
            hbuf[t * 512 + c] = hh; }
        __syncthreads();
#pragma unroll
        for (int tt = 0; tt < 2; ++tt) { const int t = 2 * w + tt, c8 = lane * 8;
            const f32x4 a = *(const f32x4*)(hbuf + t * 512 + c8), b = *(const f32x4*)(hbuf + t * 512 + c8 + 4);
            const float mean = wave_sum((a[0] + a[1]) + (a[2] + a[3]) + (b[0] + b[1]) + (b[2] + b[3])) * (1.f / 512.f);
            const f32x4 da = a - mean, db = b - mean;
            const float var = wave_sum((da[0] * da[0] + da[1] * da[1]) + (da[2] * da[2] + da[3] * da[3]) + (db[0] * db[0] + db[1] * db[1]) + (db[2] * db[2] + db[3] * db[3])) * (1.f / 512.f);
            const float rstd = rsqrtf(var + EPS);
            const float* gp = p.d_norm_g + l * 512 + c8; const float* bp = p.d_norm_b + l * 512 + c8;
            const f32x4 g0 = *(const f32x4*)gp, g1 = *(const f32x4*)(gp + 4), b0 = *(const f32x4*)bp, b1 = *(const f32x4*)(bp + 4);
            const f32x4 y0 = da * rstd * g0 + b0, y1 = db * rstd * g1 + b1;
            bf16_t* zp = Zd + (size_t)(r0 + t) * 512 + c8; const u32x4 zw = *(const u32x4*)zp;
            u32x4 ow;
            ow.x = pk2(silu(y0[0]) * silu(bf2f(zw.x & 0xffffu)), silu(y0[1]) * silu(bf2f(zw.x >> 16)));
            ow.y = pk2(silu(y0[2]) * silu(bf2f(zw.y & 0xffffu)), silu(y0[3]) * silu(bf2f(zw.y >> 16)));
            ow.z = pk2(silu(y1[0]) * silu(bf2f(zw.z & 0xffffu)), silu(y1[1]) * silu(bf2f(zw.z >> 16)));
            ow.w = pk2(silu(y1[2]) * silu(bf2f(zw.w & 0xffffu)), silu(y1[3]) * silu(bf2f(zw.w >> 16)));
            if (!dry) *(u32x4*)zp = ow; }
        __syncthreads();
    }
}
#define GLA_PT 72
__device__ __forceinline__ int gla_cidx(int c, int dir) { return dir == 0 ? c : (c < 4 ? 3 - c : 39 - c); }
__device__ __forceinline__ void gla_gates(const float* rl, int pitch, const float (&w2c)[16], float b2, int dir, int w, int d, float* segtot, float (&cum)[8], float& tot) {
    float gl[8];
#pragma unroll
    for (int e = 0; e < 8; ++e) { const float* rp = rl + (w * 8 + e) * pitch; float z = b2;
#pragma unroll
        for (int m4 = 0; m4 < 4; ++m4) { const f32x4 rv = *(const f32x4*)(rp + m4 * 4); z += rv[0] * w2c[m4 * 4] + rv[1] * w2c[m4 * 4 + 1] + rv[2] * w2c[m4 * 4 + 2] + rv[3] * w2c[m4 * 4 + 3]; }
        gl[e] = (fminf(z, 0.f) - __logf(1.f + __expf(-fabsf(z)))) * (1.f / 16.f); }
    float run = 0.f;
    if (dir == 0) {
#pragma unroll
        for (int e = 0; e < 8; ++e) { run += gl[e]; cum[e] = run; }
    } else {
#pragma unroll
        for (int e = 7; e >= 0; --e) { run += gl[e]; cum[e] = run; }
    }
    segtot[w * 64 + d] = run;
    __syncthreads();
    float off = 0.f; tot = 0.f;
#pragma unroll
    for (int s2 = 0; s2 < 8; ++s2) { const float sv = segtot[s2 * 64 + d]; tot += sv; if (dir == 0 ? (s2 < w) : (s2 > w)) off += sv; }
#pragma unroll
    for (int e = 0; e < 8; ++e) cum[e] += off;
}
__device__ __forceinline__ float* gla_U(const Params& p) { return (float*)(p.ws + WS_P + (size_t)p.tg * NCOL * 2); }
__device__ __forceinline__ float* gla_Dk(const Params& p) { return (float*)(p.ws + WS_P + (size_t)p.tg * NCOL * 2 + (size_t)p.tg * 4096); }
__device__ __forceinline__ void gla_g1(const Params& p, int l, int g, int item, unsigned char* lds) {
    const int tid = otid(), lane = tid & 63, w = tid >> 6, fr = lane & 15, fq = lane >> 4, tg = p.tg, d = lane;
    const int c = item % 36, x = item / 36, dir = x & 1, h = (x >> 1) & 3, bl = x >> 3;
    const bf16_t* Ck = subbuf(p, C_CK); const bf16_t* Cv = subbuf(p, C_CV);
    const float* R = (const float*)(p.ws + WS_R) + (size_t)g * tg * 32;
    bf16_t* Kht = (bf16_t*)lds; bf16_t* Vt = Kht + 64 * GLA_PT; float* rl = (float*)(Vt + 128 * GLA_PT); float* segtot = rl + 1024;
    bf16_t* ks = (bf16_t*)(segtot + 512); float* wl = (float*)(ks + 64 * GLA_PT);
    const int base = bl * TPB + c * 64;
    *(u32x4*)(ks + (tid >> 3) * GLA_PT + (tid & 7) * 8) = *(const u32x4*)(Ck + (size_t)(base + (tid >> 3)) * 256 + h * 64 + (tid & 7) * 8);
    if (tid < 256) *(f32x4*)(wl + (tid >> 4) * 64 + (tid & 15) * 4) = *(const f32x4*)(p.c_gate_w2 + (((size_t)l * 2 + dir) * 16 + (tid >> 4)) * 256 + h * 64 + (tid & 15) * 4);
    const float b2 = p.c_gate_b[((size_t)l * 2 + dir) * 256 + h * 64 + d];
    u32x4 vc[2];
#pragma unroll
    for (int u2 = 0; u2 < 2; ++u2) { const int idx = tid + 512 * u2; vc[u2] = *(const u32x4*)(Cv + (size_t)(base + (idx >> 4)) * 512 + h * 128 + (idx & 15) * 8); }
    if (tid < 256) *(f32x4*)(rl + (tid >> 2) * 16 + (tid & 3) * 4) = *(const f32x4*)(R + (size_t)(base + (tid >> 2)) * 32 + dir * 16 + (tid & 3) * 4);
#pragma unroll
    for (int u2 = 0; u2 < 2; ++u2) { const int idx = tid + 512 * u2, j = idx >> 4, vg = idx & 15;
#pragma unroll
        for (int e = 0; e < 4; ++e) { Vt[(vg * 8 + 2 * e) * GLA_PT + j] = (bf16_t)(vc[u2][e] & 0xffffu); Vt[(vg * 8 + 2 * e + 1) * GLA_PT + j] = (bf16_t)(vc[u2][e] >> 16); } }
    __syncthreads();
    float w2c[16], kc[8];
#pragma unroll
    for (int m = 0; m < 16; ++m) w2c[m] = wl[m * 64 + d];
#pragma unroll
    for (int e = 0; e < 8; ++e) kc[e] = bf2f(ks[(w * 8 + e) * GLA_PT + d]);
    float cum[8], tot;
    gla_gates(rl, 16, w2c, b2, dir, w, d, segtot, cum, tot);
    { unsigned kh[8];
#pragma unroll
      for (int e = 0; e < 8; ++e) kh[e] = f2bf(kc[e] * __expf(tot - cum[e]));
      u32x4 kw; kw.x = kh[0] | (kh[1] << 16); kw.y = kh[2] | (kh[3] << 16); kw.z = kh[4] | (kh[5] << 16); kw.w = kh[6] | (kh[7] << 16);
      *(u32x4*)(Kht + d * GLA_PT + w * 8) = kw; }
    __syncthreads();
    const int uidx = x * 36 + gla_cidx(c, dir);
    float* Up = gla_U(p) + (size_t)uidx * 8192;
    bf16x8 aV[2];
#pragma unroll
    for (int ks = 0; ks < 2; ++ks) aV[ks] = *(const bf16x8*)(Vt + (w * 16 + fr) * GLA_PT + ks * 32 + fq * 8);
#pragma unroll
    for (int dt = 0; dt < 4; ++dt) { f32x4 acc = {0.f, 0.f, 0.f, 0.f};
#pragma unroll
        for (int ks = 0; ks < 2; ++ks) { const bf16x8 bK = *(const bf16x8*)(Kht + (dt * 16 + fr) * GLA_PT + ks * 32 + fq * 8); acc = __builtin_amdgcn_mfma_f32_16x16x32_bf16(aV[ks], bK, acc, 0, 0, 0); }
#pragma unroll
        for (int jj = 0; jj < 4; ++jj) Up[(w * 16 + fq * 4 + jj) * 64 + dt * 16 + fr] = acc[jj]; }
    if (w == 0) gla_Dk(p)[(size_t)uidx * 64 + d] = __expf(tot);
}
__device__ __forceinline__ void gla_g2(const Params& p, bool dry = false) {
    const int nchain = (p.tg / TPB) * 8, tid = otid();
    float* U = gla_U(p); const float* Dk = gla_Dk(p);
    for (int idx = blockIdx.x * 512 + tid; idx < nchain * 2048; idx += gridDim.x * 512) {
        const int x = idx >> 11, e4 = idx & 2047;
        float* up = U + (size_t)x * 36 * 8192 + e4 * 4; const float* dk = Dk + (size_t)x * 36 * 64 + (e4 & 15) * 4;
        f32x4 S = {0.f, 0.f, 0.f, 0.f};
#pragma unroll 1
        for (int cb = 0; cb < 36; cb += 12) {
            f32x4 t[12], dc[12];
#pragma unroll
            for (int i = 0; i < 12; ++i) { t[i] = *(const f32x4*)(up + (size_t)(cb + i) * 8192); dc[i] = *(const f32x4*)(dk + (cb + i) * 64); }
#pragma unroll
            for (int i = 0; i < 12; ++i) { if (!dry) *(f32x4*)(up + (size_t)(cb + i) * 8192) = S; S = dc[i] * S + t[i]; }
            if (dry && S[0] == 12345.678f) *(f32x4*)up = S;
        }
    }
}
__device__ __forceinline__ void gla_g3(const Params& p, int l, int g, int bl, int h, int c, unsigned char* lds, bool dry = false) {
    const int tid = otid(), lane = tid & 63, w = tid >> 6, fr = lane & 15, fq = lane >> 4, tg = p.tg, d = lane;
    const bf16_t* Cq = subbuf(p, C_CQ); const bf16_t* Ck = subbuf(p, C_CK); const bf16_t* Cv = subbuf(p, C_CV); bf16_t* Zc = subbuf(p, C_ZC);
    const float* R = (const float*)(p.ws + WS_R) + (size_t)g * tg * 32;
    bf16_t* Qt = (bf16_t*)lds; bf16_t* Kt = Qt + 64 * GLA_PT; bf16_t* As = Kt + 64 * GLA_PT; bf16_t* Vt = As + 64 * GLA_PT;
    float* rl = (float*)(Vt + 128 * GLA_PT); float* segtot = rl + 2048; float* part = segtot + 512;
    bf16_t* qs = (bf16_t*)(part + 512); bf16_t* ks = qs + 64 * GLA_PT; float* wl = (float*)(ks + 64 * GLA_PT); float* ot = wl + 2048;
    const int base = bl * TPB + c * 64;
    { const size_t o = (size_t)(base + (tid >> 3)) * 256 + h * 64 + (tid & 7) * 8;
      *(u32x4*)(qs + (tid >> 3) * GLA_PT + (tid & 7) * 8) = *(const u32x4*)(Cq + o); *(u32x4*)(ks + (tid >> 3) * GLA_PT + (tid & 7) * 8) = *(const u32x4*)(Ck + o);
      *(f32x4*)(wl + tid * 4) = *(const f32x4*)(p.c_gate_w2 + (((size_t)l * 2 + (tid >> 8)) * 16 + ((tid >> 4) & 15)) * 256 + h * 64 + (tid & 15) * 4); }
    u32x4 vc[2];
#pragma unroll
    for (int u2 = 0; u2 < 2; ++u2) { const int idx = tid + 512 * u2; vc[u2] = *(const u32x4*)(Cv + (size_t)(base + (idx >> 4)) * 512 + h * 128 + (idx & 15) * 8); }
    *(f32x4*)(rl + (tid >> 3) * 32 + (tid & 7) * 4) = *(const f32x4*)(R + (size_t)(base + (tid >> 3)) * 32 + (tid & 7) * 4);
#pragma unroll
    for (int u2 = 0; u2 < 2; ++u2) { const int idx = tid + 512 * u2, j = idx >> 4, vg = idx & 15;
#pragma unroll
        for (int e = 0; e < 4; ++e) { Vt[(vg * 8 + 2 * e) * GLA_PT + j] = (bf16_t)(vc[u2][e] & 0xffffu); Vt[(vg * 8 + 2 * e + 1) * GLA_PT + j] = (bf16_t)(vc[u2][e] >> 16); } }
    bf16x8 bSall[2][2];
#pragma unroll
    for (int dir = 0; dir < 2; ++dir) { const float* Sp = gla_U(p) + (size_t)(((bl * 4 + h) * 2 + dir) * 36 + gla_cidx(c, dir)) * 8192 + (w * 16 + fr) * 64 + fq * 8;
#pragma unroll
        for (int ks = 0; ks < 2; ++ks) { const f32x4 s0 = *(const f32x4*)(Sp + ks * 32), s1 = *(const f32x4*)(Sp + ks * 32 + 4);
            u32x4 sw; sw.x = pk2(s0[0], s0[1]); sw.y = pk2(s0[2], s0[3]); sw.z = pk2(s1[0], s1[1]); sw.w = pk2(s1[2], s1[3]); bSall[dir][ks] = __builtin_bit_cast(bf16x8, sw); } }
    f32x4 acc[4];
#pragma unroll
    for (int m = 0; m < 4; ++m) acc[m] = (f32x4){0.f, 0.f, 0.f, 0.f};
    __syncthreads();
    float qc[8], kc[8];
#pragma unroll
    for (int e = 0; e < 8; ++e) { qc[e] = bf2f(qs[(w * 8 + e) * GLA_PT + d]) * 0.125f; kc[e] = bf2f(ks[(w * 8 + e) * GLA_PT + d]); }
#pragma unroll
    for (int dir = 0; dir < 2; ++dir) {
        float w2c[16];
#pragma unroll
        for (int m = 0; m < 16; ++m) w2c[m] = wl[(dir * 16 + m) * 64 + d];
        const float b2 = p.c_gate_b[((size_t)l * 2 + dir) * 256 + h * 64 + d];
        const bf16x8 bS[2] = {bSall[dir][0], bSall[dir][1]};
        __syncthreads();
        float cum[8], tot;
        gla_gates(rl + dir * 16, 32, w2c, b2, dir, w, d, segtot, cum, tot);
#pragma unroll
        for (int e = 0; e < 8; ++e) { const int i = w * 8 + e; Qt[i * GLA_PT + d] = (bf16_t)f2bf(qc[e] * __expf(cum[e])); Kt[i * GLA_PT + d] = (bf16_t)f2bf(kc[e] * __expf(-cum[e])); }
        __syncthreads();
        { const int m = w >> 1;
#pragma unroll
          for (int nn = 0; nn < 2; ++nn) { const int n = (w & 1) * 2 + nn; f32x4 sc = {0.f, 0.f, 0.f, 0.f};
#pragma unroll
              for (int ks = 0; ks < 2; ++ks) { const bf16x8 a = *(const bf16x8*)(Qt + (m * 16 + fr) * GLA_PT + ks * 32 + fq * 8), b = *(const bf16x8*)(Kt + (n * 16 + fr) * GLA_PT + ks * 32 + fq * 8);
                  sc = __builtin_amdgcn_mfma_f32_16x16x32_bf16(a, b, sc, 0, 0, 0); }
#pragma unroll
              for (int jj = 0; jj < 4; ++jj) { const int i = m * 16 + fq * 4 + jj, j = n * 16 + fr; const bool keep = dir == 0 ? (j <= i) : (j >= i);
                  As[i * GLA_PT + j] = keep ? (bf16_t)f2bf(sc[jj]) : (bf16_t)0; } } }
        __syncthreads();
        bf16x8 bV[2];
#pragma unroll
        for (int ks = 0; ks < 2; ++ks) bV[ks] = *(const bf16x8*)(Vt + (w * 16 + fr) * GLA_PT + ks * 32 + fq * 8);
#pragma unroll
        for (int m = 0; m < 4; ++m) {
#pragma unroll
            for (int ks = 0; ks < 2; ++ks) { const bf16x8 aA = *(const bf16x8*)(As + (m * 16 + fr) * GLA_PT + ks * 32 + fq * 8), aQ = *(const bf16x8*)(Qt + (m * 16 + fr) * GLA_PT + ks * 32 + fq * 8);
                acc[m] = __builtin_amdgcn_mfma_f32_16x16x32_bf16(aA, bV[ks], acc[m], 0, 0, 0); acc[m] = __builtin_amdgcn_mfma_f32_16x16x32_bf16(aQ, bS[ks], acc[m], 0, 0, 0); } }
    }
#pragma unroll
    for (int m = 0; m < 4; ++m)
#pragma unroll
        for (int jj = 0; jj < 4; ++jj) { float sq = acc[m][jj] * acc[m][jj]; sq += __shfl_xor(sq, 1); sq += __shfl_xor(sq, 2); sq += __shfl_xor(sq, 4); sq += __shfl_xor(sq, 8);
            if (fr == 0) part[w * 64 + m * 16 + fq * 4 + jj] = sq; }
    __syncthreads();
    const float cn = p.c_norm[l * 512 + h * 128 + w * 16 + fr];
#pragma unroll
    for (int m = 0; m < 4; ++m)
#pragma unroll
        for (int jj = 0; jj < 4; ++jj) { const int row = m * 16 + fq * 4 + jj; float ss = 0.f;
#pragma unroll
            for (int w2 = 0; w2 < 8; ++w2) ss += part[w2 * 64 + row];
            ot[row * 132 + w * 16 + fr] = acc[m][jj] * rsqrtf(ss * (1.f / 128.f) + EPS) * cn; }
    __syncthreads();
#pragma unroll
    for (int u2 = 0; u2 < 2; ++u2) { const int idx = tid + 512 * u2, row = idx >> 4, c8 = (idx & 15) * 8;
        bf16_t* zp = Zc + (size_t)(base + row) * 512 + h * 128 + c8; const u32x4 zw = *(const u32x4*)zp;
        const f32x4 o0 = *(const f32x4*)(ot + row * 132 + c8), o1 = *(const f32x4*)(ot + row * 132 + c8 + 4);
        u32x4 ow;
        ow.x = pk2(o0[0] * silu(bf2f(zw.x & 0xffffu)), o0[1] * silu(bf2f(zw.x >> 16))); ow.y = pk2(o0[2] * silu(bf2f(zw.y & 0xffffu)), o0[3] * silu(bf2f(zw.y >> 16)));
        ow.z = pk2(o1[0] * silu(bf2f(zw.z & 0xffffu)), o1[1] * silu(bf2f(zw.z >> 16))); ow.w = pk2(o1[2] * silu(bf2f(zw.w & 0xffffu)), o1[3] * silu(bf2f(zw.w >> 16)));
        if (!dry) *(u32x4*)zp = ow; }
}
#define LAS __attribute__((address_space(3)))
#define XB_TMO      128
#define XB_XCNT(j)  (256  + 64 * (j))
#define XB_XSUB(j)  (1280 + 64 * (j))
#define XB_XGEN(j)  (2304 + 64 * (j))
#define XB_TOP      3328
#define XB_TOPGEN   3392
#define XCD_BAR_WORDS 3456
#define XB_SPIN_CAP (1u << 18)

__device__ __forceinline__ unsigned xb_ld(unsigned* p)              { return __hip_atomic_load(p, __ATOMIC_RELAXED, __HIP_MEMORY_SCOPE_AGENT); }
__device__ __forceinline__ unsigned xb_add(unsigned* p, unsigned v) { return __hip_atomic_fetch_add(p, v, __ATOMIC_RELAXED, __HIP_MEMORY_SCOPE_AGENT); }
__device__ __forceinline__ unsigned xb_xcc_id() { return (unsigned)__builtin_amdgcn_s_getreg((3 << 11) | 20) & 0xFu; }
#define XB_SPIN(cond, bar) do { unsigned _sp = 0; while (cond) { __builtin_amdgcn_s_sleep(1); \
    if ((++_sp & 255u) == 0u) { if (xb_ld(&(bar)[XB_TMO])) break; if (_sp > XB_SPIN_CAP) { atomicAdd(&(bar)[XB_TMO], 1u); break; } } } } while (0)

struct XcdBarrier {
    unsigned* bar; unsigned x;
    volatile LAS unsigned* st;
};

__device__ __forceinline__ XcdBarrier xcd_barrier_post(unsigned* bar, volatile LAS unsigned* st) {
    XcdBarrier b; b.bar = bar; b.x = xb_xcc_id(); b.st = st;
    if (threadIdx.x == 0) (void)xb_add(&bar[XB_XCNT(b.x)], 1u);
    return b;
}
__device__ __forceinline__ void xcd_barrier_complete(unsigned* bar, unsigned x, unsigned& nloc, unsigned& nx) {
    const unsigned G = gridDim.x * gridDim.y * gridDim.z;
    unsigned sum, cnt, mine, sp = 0u;
    for (;;) {
        sum = 0u; cnt = 0u; mine = 0u;
#pragma unroll
        for (unsigned j = 0; j < 16; ++j) { const unsigned c = xb_ld(&bar[XB_XCNT(j)]); sum += c; cnt += (c > 0u) ? 1u : 0u; mine = (j == x) ? c : mine; }
        if (sum == G) break;
        __builtin_amdgcn_s_sleep(1);
        if ((++sp & 255u) == 0u) { if (xb_ld(&bar[XB_TMO])) break; if (sp > XB_SPIN_CAP) { atomicAdd(&bar[XB_TMO], 1u); break; } }
    }
    nloc = mine > 0u ? mine : 1u; nx = cnt > 0u ? cnt : 1u;
}

__device__ __forceinline__ void xcd_barrier(const XcdBarrier& b) {
    asm volatile("s_waitcnt vmcnt(0)" ::: "memory");
    __syncthreads();
    if (threadIdx.x == 0) {
        unsigned* bar = b.bar;
        __builtin_amdgcn_s_waitcnt(0);
        unsigned nloc = b.st[0], nx = b.st[1];
        if (nloc == 0u) { xcd_barrier_complete(bar, b.x, nloc, nx); b.st[0] = nloc; b.st[1] = nx; }
        const unsigned old = xb_add(&bar[XB_XSUB(b.x)], 1u);
        const unsigned gen = old / nloc;
        if (old + 1u == (gen + 1u) * nloc) {
            __builtin_amdgcn_fence(__ATOMIC_RELEASE, "agent");
            asm volatile("s_waitcnt vmcnt(0)" ::: "memory");
            const unsigned og = xb_add(&bar[XB_TOP], 1u);
            const unsigned tg = og / nx;
            if (og + 1u == (tg + 1u) * nx) xb_add(&bar[XB_TOPGEN], 1u);
            else XB_SPIN(xb_ld(&bar[XB_TOPGEN]) == tg, bar);
            __builtin_amdgcn_fence(__ATOMIC_ACQUIRE, "agent");
            xb_add(&bar[XB_XGEN(b.x)], 1u);
            asm volatile("s_waitcnt vmcnt(0)" ::: "memory");
        } else {
            XB_SPIN(xb_ld(&bar[XB_XGEN(b.x)]) == gen, bar);
            __builtin_amdgcn_fence(__ATOMIC_ACQUIRE, "agent");
            asm volatile("s_waitcnt vmcnt(0)" ::: "memory");
        }
    }
    __syncthreads();
}
__device__ __forceinline__ void sum_branches(const Params& p, const bf16_t* Gb, bf16_t* merged) {
    const int tid_ = otid(); const size_t n8 = (size_t)p.tg * 128, gs = (size_t)p.tg * 1024;
    for (size_t i = (size_t)blockIdx.x * 512 + tid_; i < n8; i += (size_t)gridDim.x * 512) {
        const u32x4 a = *(const u32x4*)(Gb + i * 8), b = *(const u32x4*)(Gb + gs + i * 8), c = *(const u32x4*)(Gb + 2 * gs + i * 8), d = *(const u32x4*)(Gb + 3 * gs + i * 8);
        u32x4 o;
#pragma unroll
        for (int e = 0; e < 4; ++e) {
            const float lo = (bf2f(a[e] & 0xffffu) + bf2f(b[e] & 0xffffu)) + (bf2f(c[e] & 0xffffu) + bf2f(d[e] & 0xffffu));
            const float hi = (bf2f(a[e] >> 16) + bf2f(b[e] >> 16)) + (bf2f(c[e] >> 16) + bf2f(d[e] >> 16));
            o[e] = pk2(lo, hi); }
        *(u32x4*)(merged + i * 8) = o;
    }
}
__global__ void __launch_bounds__(512, 2) hybrid_block_fwd(Params p) {
    extern __shared__ __attribute__((aligned(16))) unsigned char lds[];
    cg::grid_group grid = cg::this_grid();
    if (p.ng < 0) grid.sync();
    volatile LAS unsigned* xst = (volatile LAS unsigned*)((LAS unsigned char*)lds + 131072);
    if (threadIdx.x < 2) xst[threadIdx.x] = 0u;
    __syncthreads();
    XcdBarrier xbar = xcd_barrier_post((unsigned*)(p.ws + WS_BAR), xst);
    const int tg = p.tg, G = gridDim.x, bid = blockIdx.x, nb = tg / TPB, tpg = tg / 256;
    const bool dryflag = p.ng > 0;
#if PROBING
    unsigned accA = 0, accB = 0; unsigned long long tprev = __builtin_amdgcn_s_memrealtime();
#define STAMP(k) do { const unsigned long long _now = __builtin_amdgcn_s_memrealtime(); if ((k) == PROBE_A) accA += (unsigned)(_now - tprev); if ((k) == PROBE_B) accB += (unsigned)(_now - tprev); tprev = _now; } while (0)
#else
#define STAMP(k) do { } while (0)
#endif
#if PH & 1
    phase0(p, lds);
#endif
#if REP & 8
    GSYNC(); phase0(p, lds);
#endif
    GSYNC(); STAMP(0);
#if PH & 2
    ln_phase(p, 0, 0, 0, 0, NTOK, nullptr);
#endif
    GSYNC(); STAMP(1);
#pragma unroll 1
    for (int l = 0; l < 2; ++l) {
#pragma unroll 1
        for (int g = 0; g < p.ng; ++g) {
            const bool last = (l == 1);
            r_items(p, l, g, lds);
            {
                pg8::Gemm gm{(const bf16_t*)(p.ws + WS_U) + (size_t)g * tg * 1024, (const bf16_t*)(p.ws + WS_WIN) + (size_t)l * NCOL * 1024, tg, NCOL, 1024};
                pg8::StaticOrder S; S.init(tg, NCOL, G, bid);
                pg8::EpiP E{p.ws + WS_P, tg};
#if PH & 4
                pg8::gemm_phase<pg8::EpiP, pg8::StaticOrder, true, true>((PG8_LAS unsigned char*)lds, gm, S, E);
#endif
#if REP & 16
                GSYNC();
                pg8::gemm_phase<pg8::EpiP, pg8::StaticOrder, true, true>((PG8_LAS unsigned char*)lds, gm, S, E);
#endif
            }
            GSYNC(); STAMP(2);
#if PH & 8
            qk_prep(p, l);
            short_conv(p, l);
            __syncthreads();
#endif
#if PH & 16
            conformer(p, l, lds, false, last);
#endif
            { const int n_g1 = nb * 8 * 36; for (int it = bid; it < n_g1; it += G) { __syncthreads(); gla_g1(p, l, g, it, lds); } }
            GSYNC();
#if REP & 1024
            conformer(p, l, lds, dryflag); GSYNC();
#endif
#if REP & 2048
            { const int n_g1 = nb * 8 * 36; for (int it = bid; it < n_g1; it += G) { __syncthreads(); gla_g1(p, l, g, it, lds); } } GSYNC();
#endif
#if REP & 128
            qk_prep(p, l, dryflag); short_conv(p, l, dryflag); __syncthreads(); conformer(p, l, lds, dryflag);
            { const int n_g1 = nb * 8 * 36; for (int it = bid; it < n_g1; it += G) { __syncthreads(); gla_g1(p, l, g, it, lds); } }
            GSYNC();
#endif
            gla_g2(p);
#if REP & 512
            GSYNC(); gla_g2(p, dryflag);
#endif
            GSYNC(); STAMP(3);
            {
                const int n_att_lat = nb * 32, n_ctx = last ? 0 : nb * 4, nck = last ? 32 : 36, c0 = last ? 4 : 0, n_g3 = nb * 4 * nck;
                const bf16_t* Aq = subbuf(p, C_AQ); const bf16_t* Ak = subbuf(p, C_AK); const bf16_t* Av = subbuf(p, C_AV); bf16_t* Za = subbuf(p, C_ZA);
                const bool split = G >= n_att_lat + 32;
                int it = bid; const int n_all = n_att_lat + n_ctx + n_g3;
                const int stride = split ? (bid < n_att_lat ? n_all : G - n_att_lat) : G;
                for (; it < n_all; it += stride) {
                    __syncthreads();
                    if (it >= n_att_lat + n_ctx) { const int a = it - n_att_lat - n_ctx, ci = a % nck, bh = a / nck; gla_g3(p, l, g, bh >> 2, bh & 3, c0 + ci, lds); continue; }
                    const int a = (it < n_att_lat && (n_att_lat & 7) == 0) ? (it & 7) * (n_att_lat >> 3) + (it >> 3) : it;
                    int bl, h, qrow0, seq;
                    if (a < n_att_lat) { bl = a >> 5; h = (a >> 3) & 3; qrow0 = bl * TPB + CTX + (a & 7) * 256; seq = TPB; }
                    else { const int a2 = a - n_att_lat; bl = a2 >> 2; h = a2 & 3; qrow0 = bl * TPB; seq = CTX; }
                    const size_t kvo = (size_t)(bl * TPB) * 256 + (h >> 1) * 128;
                    att::attn_dense_body((const att::bf16*)(Aq + (size_t)qrow0 * 512 + h * 128), (const att::bf16*)(Ak + kvo), (const att::bf16*)(Av + kvo),
                                         Za + (size_t)qrow0 * 512 + h * 128, seq, (char*)lds);
                }
            }
            GSYNC(); STAMP(4);
            bf16_t* Gbuf = (bf16_t*)(p.ws + WS_P);
            bf16_t* merged = (bf16_t*)(p.ws + WS_U) + (size_t)g * tg * 1024;
            {
                pg8::Gemm gm{subbuf(p, C_ZA), (const bf16_t*)(p.ws + WS_WBR) + (size_t)l * 4 * 1024 * 512, tg, 1024, 512};
                pg8::BrOrder2 S{last ? (tpg / 9) * 8 * 4 : tpg * 4, G, bid, tpg, last};
                pg8::EpiBr2 E{subbuf(p, C_MG), Gbuf, tpg, (size_t)tg * 1024};
                pg8::gemm_phase<pg8::EpiBr2, pg8::BrOrder2, true, true>((PG8_LAS unsigned char*)lds, gm, S, E);
            }
            GSYNC();
            sum_branches(p, Gbuf, merged);
            GSYNC(); STAMP(6);
            float* hpre = gla_U(p);
            {
                pg8::Gemm gm{merged, (const bf16_t*)(p.ws + WS_WOUT) + (size_t)l * 1024 * 1024, tg, 1024, 1024};
                pg8::StaticOrder S; S.init(tg, 1024, G, bid);
                pg8::EpiOut E{p, hpre, l, g};
#if PH & 512
                pg8::gemm_phase<pg8::EpiOut, pg8::StaticOrder, true, true>((PG8_LAS unsigned char*)lds, gm, S, E);
#endif
#if REP & 32
                GSYNC();
                pg8::gemm_phase<pg8::EpiOut, pg8::StaticOrder, true, true>((PG8_LAS unsigned char*)lds, gm, S, E);
#endif
            }
            GSYNC(); STAMP(7);
#if PH & 1024
            ln_phase(p, last ? 2 : 1, l, last ? 1 : l + 1, g * tg, tg, hpre);
#endif
        }
    }
#if PROBING
    if (bid == 0) { float* ex = (float*)lds; if (threadIdx.x == 0) { ex[0] = (float)accA * 0.01f; ex[1] = (float)accB * 0.001f; } __syncthreads();
        if (PROBE_A >= 0 && threadIdx.x == 0) p.out[0] = ex[0];
        if (PROBE_B >= 0) for (int i = threadIdx.x; i < 10000; i += 512) p.out[1024 + i] = ex[1]; }
#endif
}

extern "C" void kernel_launch(void* const* d_in, const int* in_sizes, int n_in, void* d_out, int out_size, void* d_ws, size_t ws_size, hipStream_t stream) {
    static int grid_blocks = 0;
    if (grid_blocks == 0) {
        int dev = 0, cus = 0, per_cu = 0;
        hipGetDevice(&dev);
        hipDeviceGetAttribute(&cus, hipDeviceAttributeMultiprocessorCount, dev);
        hipFuncSetAttribute((const void*)hybrid_block_fwd, hipFuncAttributeMaxDynamicSharedMemorySize, LDS_BYTES);
        hipOccupancyMaxActiveBlocksPerMultiprocessor(&per_cu, (const void*)hybrid_block_fwd, 512, LDS_BYTES);
        if (per_cu < 1) { fprintf(stderr, "kernel_launch: occupancy query reports %d blocks per CU\n", per_cu); per_cu = 1; }
        if (per_cu > 1) per_cu = 1;
        grid_blocks = cus * per_cu;
    }
    Params p{};
    const float** f = (const float**)&p;
    for (int i = 0; i < 21; ++i) f[i] = (const float*)d_in[i];
    p.out = (float*)d_out; p.ws = (unsigned char*)d_ws;
    p.ng = (ws_size >= WS_P + (size_t)9216 * (NCOL * 2 + 4096) + (1u << 20)) ? 2 : 4;
    p.tg = NTOK / p.ng;
    hipMemsetAsync((char*)d_ws + WS_BAR, 0, 16384, stream);
    void* args[] = {&p};
    hipError_t e = hipLaunchCooperativeKernel((const void*)hybrid_block_fwd, dim3(grid_blocks), dim3(512), args, LDS_BYTES, stream);
    if (e != hipSuccess) fprintf(stderr, "cooperative launch failed: %s (grid %d)\n", hipGetErrorString(e), grid_blocks);
}
```

```cpp
#include <hip/hip_runtime.h>
#include <hip/hip_bf16.h>
#include <hip/hip_cooperative_groups.h>
#include <cstdio>
#include <cstdint>
namespace cg = cooperative_groups;
#ifndef PH
#define PH 2047
#endif
#ifndef PROBE_A
#define PROBE_A -1
#endif
#ifndef PROBE_B
#define PROBE_B -1
#endif
#define PROBING (PROBE_A >= 0 || PROBE_B >= 0)
#ifndef REP
#define REP 0
#endif
#if REP & 4
#define GSYNC() do { xcd_barrier(xbar); xcd_barrier(xbar); } while (0)
#else
#define GSYNC() xcd_barrier(xbar)
#endif

constexpr int DM = 1024, NBATCH = 8, SEQ = 2048, CTX = 256, TPB = CTX + SEQ, NTOK = NBATCH * TPB;
constexpr int NCOL = 10752, WIN_COLS = 10784;
constexpr float EPS = 1e-6f, ALPHA = 1.41421356237f;
constexpr int C_BG = 0, C_CG = 512, C_XIN = 1024, C_GLU = 1536, C_AQ = 2560, C_AK = 3072, C_AV = 3328, C_CQ = 3584, C_CK = 3840, C_CV = 4096,
              C_ZA = 4608, C_ZB = 5120, C_ZC = 5632, C_ZD = 6144, C_MG = 6656;
constexpr size_t WS_WIN = 0;
constexpr size_t WS_WR = WS_WIN + (size_t)2 * NCOL * 1024 * 2;
constexpr size_t WS_WBR = WS_WR + (size_t)2 * 32 * 1024 * 2;
constexpr size_t WS_WOUT = WS_WBR + (size_t)2 * 4 * 1024 * 512 * 2;
constexpr size_t WS_MOD = WS_WOUT + (size_t)2 * 1024 * 1024 * 2;
constexpr size_t WS_U = WS_MOD + (size_t)2 * 9 * 3072 * 4;
constexpr size_t WS_R = WS_U + (size_t)NTOK * 1024 * 2;
constexpr size_t WS_HCTX = WS_R + (size_t)NTOK * 32 * 4;
constexpr size_t WS_BAR = WS_HCTX + (size_t)NBATCH * CTX * 1024 * 4;
constexpr size_t WS_P = WS_BAR + 16384;
constexpr int LDS_BYTES = 131072 + 1024;

typedef unsigned short bf16_t;
typedef short bf16x8 __attribute__((ext_vector_type(8)));
typedef float f32x4 __attribute__((ext_vector_type(4)));
typedef unsigned u32x4 __attribute__((ext_vector_type(4)));

struct Params {
    const float *x, *c, *ctx, *c_ctx, *w_mod, *b_mod, *w_in, *q_norm, *k_norm, *b_conv, *c_gate_w2, *c_gate_b, *c_norm,
                *d_conv_w, *d_conv_b, *d_norm_g, *d_norm_b, *w_br, *w_out, *ln_g, *ln_b;
    float* out; unsigned char* ws;
    int ng, tg;
};

__device__ __forceinline__ int otid() { int t = threadIdx.x; asm volatile("" : "+v"(t)); return t; }
__device__ __forceinline__ float bf2f(unsigned v) { return __uint_as_float(v << 16); }
__device__ __forceinline__ unsigned f2bf(float f) { unsigned u = __float_as_uint(f); return (u + 0x7fffu + ((u >> 16) & 1u)) >> 16; }
__device__ __forceinline__ unsigned pk2(float lo, float hi) { return f2bf(lo) | (f2bf(hi) << 16); }
__device__ __forceinline__ float sigm(float x) { return 1.f / (1.f + __expf(-x)); }
__device__ __forceinline__ float silu(float x) { return x / (1.f + __expf(-x)); }
__device__ __forceinline__ float wave_sum(float v) {
#pragma unroll
    for (int o = 32; o > 0; o >>= 1) v += __shfl_xor(v, o);
    return v;
}
__device__ __forceinline__ bf16_t* subbuf(const Params& p, int col) { return (bf16_t*)(p.ws + WS_P + (size_t)col * p.tg * 2); }
struct SubInfo { int col0, width, orig0; };
__device__ __forceinline__ SubInfo sub_info(int col) {
    if (col < 512) return {0, 512, 1536};
    if (col < 1024) return {512, 512, 2048};
    if (col < 1536) return {1024, 512, 2560};
    if (col < 2560) return {1536, 1024, 5152};
    if (col < 3072) return {2560, 512, 0};
    if (col < 3328) return {3072, 256, 512};
    if (col < 3584) return {3328, 256, 768};
    if (col < 3840) return {3584, 256, 3584};
    if (col < 4096) return {3840, 256, 3840};
    if (col < 4608) return {4096, 512, 4096};
    if (col < 5120) return {4608, 512, 1024};
    if (col < 5632) return {5120, 512, 3072};
    if (col < 6144) return {5632, 512, 4608};
    if (col < 6656) return {6144, 512, 6176};
    return {6656, 4096, 6688};
}
__device__ __forceinline__ const float* h_in_row(const Params& p, int l, int grow) {
    const int b = grow / TPB, s = grow % TPB;
    if (l == 0) return s < CTX ? p.ctx + ((size_t)b * CTX + s) * 1024 : p.x + ((size_t)b * SEQ + (s - CTX)) * 1024;
    return s < CTX ? (const float*)(p.ws + WS_HCTX) + ((size_t)b * CTX + s) * 1024 : p.out + ((size_t)b * SEQ + (s - CTX)) * 1024;
}
namespace att {
using bf16 = __hip_bfloat16;
constexpr int D = 128, NW = 8, QBLK = 32, KVBLK = 64;
constexpr float SCALE = 0.088388347648318440f;
constexpr float THR = 8.f;
constexpr int SDEPTH = 2;
constexpr int LDQ = 512, LDK = 256, LDZ = 512;
constexpr size_t SHM_V = KVBLK * D * 2, SHM_K = KVBLK * D * 2, SHM_ATTN = 2 * SHM_V + 2 * SHM_K + NW * 64 * 4;
using bf16x8 = __attribute__((ext_vector_type(8))) short;
using s16x4  = __attribute__((ext_vector_type(4))) short;
using f32x16 = __attribute__((ext_vector_type(16))) float;
using f32x8  = __attribute__((ext_vector_type(8))) float;
using u32x4  = __attribute__((ext_vector_type(4))) unsigned;
#define KSWZ(row, colB) ((row) * 256 + ((colB) ^ (((row) & 7) << 4)))
#define SBAR() __builtin_amdgcn_sched_barrier(0)
__device__ __forceinline__ int crow(int r, int hi) { return (r & 3) + 8 * (r >> 2) + 4 * hi; }
__device__ __forceinline__ unsigned cvtpk(float lo, float hi) {
  unsigned r; asm volatile("v_cvt_pk_bf16_f32 %0, %1, %2" : "=v"(r) : "v"(lo), "v"(hi)); return r;
}
template <typename TIn> struct Stage;
template <> struct Stage<bf16>  { using T = bf16x8;
  __device__ static __forceinline__ T ld8(const bf16* p) { return *reinterpret_cast<const bf16x8*>(p); }
  __device__ static __forceinline__ bf16x8 tobf(T x) { return x; } };
__device__ __forceinline__ void partialSM(f32x16& p0, f32x16& p1, float& m_reg, float& mn, float& alpha) {
  constexpr float C = SCALE * 1.4426950408889634f;
  float pmax = p0[0]; for (int r = 1; r < 16; ++r) pmax = fmaxf(pmax, p0[r]); for (int r = 0; r < 16; ++r) pmax = fmaxf(pmax, p1[r]);
  { auto rr = __builtin_amdgcn_permlane32_swap(__float_as_uint(pmax), __float_as_uint(pmax), false, false);
    pmax = fmaxf(__uint_as_float(rr[0]), __uint_as_float(rr[1])); }
  if (__builtin_expect(__all(pmax - m_reg <= THR / SCALE), 1)) { mn = m_reg; alpha = 1.f; }
  else { mn = fmaxf(m_reg, pmax); alpha = __builtin_amdgcn_exp2f((m_reg - mn) * C); m_reg = mn; }
  float mnC = -mn * C;
  for (int r = 0; r < 16; ++r) p0[r] = fmaf(p0[r], C, mnC); for (int r = 0; r < 16; ++r) p1[r] = fmaf(p1[r], C, mnC);
  for (int r = 0; r < 16; ++r) p0[r] = __builtin_amdgcn_exp2f(p0[r]);
}
__device__ __forceinline__ void finishSM(f32x16& p0, f32x16& p1, float alpha, float& l_reg, bf16x8& pa0, bf16x8& pa1, bf16x8& pa2, bf16x8& pa3) {
  for (int r = 0; r < 16; ++r) p1[r] = __builtin_amdgcn_exp2f(p1[r]);
  float ps = 0; for (int r = 0; r < 16; ++r) ps += p0[r]; for (int r = 0; r < 16; ++r) ps += p1[r];
  { auto rr = __builtin_amdgcn_permlane32_swap(__float_as_uint(ps), __float_as_uint(ps), false, false);
    ps = __uint_as_float(rr[0]) + __uint_as_float(rr[1]); }
  l_reg = l_reg * alpha + ps;
#define PK4(P, BASE, OUT) do { unsigned a0 = cvtpk(P[BASE + 0], P[BASE + 1]), a1 = cvtpk(P[BASE + 2], P[BASE + 3]);   \
    unsigned b0 = cvtpk(P[BASE + 4], P[BASE + 5]), b1 = cvtpk(P[BASE + 6], P[BASE + 7]);                              \
    auto r0 = __builtin_amdgcn_permlane32_swap(a0, b0, false, false); auto r1 = __builtin_amdgcn_permlane32_swap(a1, b1, false, false); \
    u32x4 w = {r0[0], r1[0], r0[1], r1[1]}; OUT = *reinterpret_cast<bf16x8*>(&w); } while (0)
  PK4(p0, 0, pa0); PK4(p0, 8, pa1); PK4(p1, 0, pa2); PK4(p1, 8, pa3);
#undef PK4
}
__device__ __forceinline__ void qkt(f32x16& p0, f32x16& p1, const bf16* Ks, const bf16x8* qr, int r32, int hi) {
  p0 = f32x16{}; p1 = f32x16{};
  for (int d0 = 0; d0 < 8; ++d0) { int cb = (d0 * 16 + hi * 8) * 2;
    bf16x8 b0 = *reinterpret_cast<const bf16x8*>((const char*)Ks + KSWZ(r32, cb));
    bf16x8 b1 = *reinterpret_cast<const bf16x8*>((const char*)Ks + KSWZ(32 + r32, cb));
    p0 = __builtin_amdgcn_mfma_f32_32x32x16_bf16(b0, qr[d0], p0, 0, 0, 0);
    p1 = __builtin_amdgcn_mfma_f32_32x32x16_bf16(b1, qr[d0], p1, 0, 0, 0); }
}
__device__ __forceinline__ int v_st(int k, int c) { const int kk = (k & ~0xC) | ((k & 4) << 1) | ((k & 8) >> 1); return ((kk >> 3) * 4 + (c >> 5)) * 512 + ((kk & 7) * 32 + (c & 31)) * 2; }
__device__ __forceinline__ int v_rd_base(int lane) { return ((lane & 3) << 3) | (((lane >> 2) & 3) << 6) | (((lane >> 4) & 1) << 5) | (((lane >> 5) & 1) << 8); }
constexpr int v_rd_off(int d0, int ks, int half) { return d0 * 512 + ks * 4096 + half * 2048; }
template <int OFF> __device__ __forceinline__ s16x4 tr_read(int vb) {
  s16x4 r; asm volatile("ds_read_b64_tr_b16 %0, %1 offset:%2" : "=&v"(r) : "v"(vb), "i"(OFF) : "memory"); return r;
}
template <int D0> __device__ __forceinline__ void pv_one(f32x16& od, int vb, bf16x8 pa0, bf16x8 pa1, bf16x8 pa2, bf16x8 pa3) {
  const s16x4 l0 = tr_read<v_rd_off(D0, 0, 0)>(vb), h0 = tr_read<v_rd_off(D0, 0, 1)>(vb), l1 = tr_read<v_rd_off(D0, 1, 0)>(vb), h1 = tr_read<v_rd_off(D0, 1, 1)>(vb);
  const s16x4 l2 = tr_read<v_rd_off(D0, 2, 0)>(vb), h2 = tr_read<v_rd_off(D0, 2, 1)>(vb), l3 = tr_read<v_rd_off(D0, 3, 0)>(vb), h3 = tr_read<v_rd_off(D0, 3, 1)>(vb);
  asm volatile("s_waitcnt lgkmcnt(0)" ::: "memory"); SBAR();
#define PK(L, H) (bf16x8){L[0], L[1], L[2], L[3], H[0], H[1], H[2], H[3]}
  od = __builtin_amdgcn_mfma_f32_32x32x16_bf16(pa0, PK(l0, h0), od, 0, 0, 0);
  od = __builtin_amdgcn_mfma_f32_32x32x16_bf16(pa1, PK(l1, h1), od, 0, 0, 0);
  od = __builtin_amdgcn_mfma_f32_32x32x16_bf16(pa2, PK(l2, h2), od, 0, 0, 0);
  od = __builtin_amdgcn_mfma_f32_32x32x16_bf16(pa3, PK(l3, h3), od, 0, 0, 0);
#undef PK
}
__device__ __forceinline__ void pv_d0(f32x16* o, int vb, bf16x8 pa0, bf16x8 pa1, bf16x8 pa2, bf16x8 pa3) {
  pv_one<0>(o[0], vb, pa0, pa1, pa2, pa3); pv_one<1>(o[1], vb, pa0, pa1, pa2, pa3); pv_one<2>(o[2], vb, pa0, pa1, pa2, pa3); pv_one<3>(o[3], vb, pa0, pa1, pa2, pa3);
}

__device__ __forceinline__ void attn_dense_body(const bf16* __restrict__ Qb, const bf16* __restrict__ Kh, const bf16* __restrict__ Vh,
                                                unsigned short* __restrict__ Zb, int seq, char* lds, bool dry = false) {
  using TQ = bf16;
  using St = Stage<bf16>; using SQ = Stage<TQ>;
  const int tid = otid(), wid = tid >> 6, lane = tid & 63, r32 = lane & 31, hi = lane >> 5;
  bf16* V_lds = (bf16*)lds; bf16* K_lds = (bf16*)(lds + 2 * SHM_V);
  float* ws = (float*)(lds + 2 * SHM_V + 2 * SHM_K) + wid * 64; float* li_l = ws; float* al_l = ws + 32;
  float m_reg = -1e30f, l_reg = 0; f32x16 o[4] = {}; bf16x8 qr[8];
  const TQ* Qw = Qb + (long)(wid * QBLK + r32) * LDQ + hi * 8;
#pragma unroll
  for (int d0 = 0; d0 < 8; ++d0) qr[d0] = SQ::tobf(SQ::ld8(Qw + d0 * 16));
  const int sr = tid >> 4, sc = (tid & 15) * 8, vst0 = v_st(sr, sc), vst1 = v_st(32 + sr, sc);
  const int vb0 = (int)(uintptr_t)V_lds + v_rd_base(lane);
  struct { typename St::T vs0, vs1, ks0, ks1; } sr_[SDEPTH];
#define SLOAD(i, k0) do { sr_[i].vs0 = St::ld8(&Vh[(long)((k0) + sr) * LDK + sc]); sr_[i].vs1 = St::ld8(&Vh[(long)((k0) + 32 + sr) * LDK + sc]); \
    sr_[i].ks0 = St::ld8(&Kh[(long)((k0) + sr) * LDK + sc]); sr_[i].ks1 = St::ld8(&Kh[(long)((k0) + 32 + sr) * LDK + sc]); } while (0)
#define SWRITE(b, i) do { *(bf16x8*)((char*)V_lds + (b) * SHM_V + vst0) = St::tobf(sr_[i].vs0);          \
    *(bf16x8*)((char*)V_lds + (b) * SHM_V + vst1) = St::tobf(sr_[i].vs1); int kc = sc * 2;               \
    *(bf16x8*)((char*)K_lds + (b) * SHM_K + KSWZ(sr, kc)) = St::tobf(sr_[i].ks0);                       \
    *(bf16x8*)((char*)K_lds + (b) * SHM_K + KSWZ(32 + sr, kc)) = St::tobf(sr_[i].ks1); } while (0)
#define SWAIT() do { if constexpr (SDEPTH == 2) asm volatile("s_waitcnt vmcnt(4)" ::: "memory"); else asm volatile("s_waitcnt vmcnt(0)" ::: "memory"); } while (0)
#define RESC(a) do { if (__any((a) < 1.f)) { if (hi == 0) al_l[r32] = (a); asm volatile("s_waitcnt lgkmcnt(0)" ::: "memory"); \
    for (int d = 0; d < 4; ++d) for (int r = 0; r < 16; ++r) o[d][r] *= al_l[crow(r, hi)]; } } while (0)
  f32x16 pA0, pA1, pB0, pB1; float mnA, mnB, alA, alB; bf16x8 pa0, pa1, pa2, pa3; const int NT = seq / KVBLK;
  constexpr int SE = 0, SO = SDEPTH - 1;
  SLOAD(SE, 0); asm volatile("s_waitcnt vmcnt(0)" ::: "memory"); SWRITE(0, SE); __syncthreads();
  qkt(pA0, pA1, K_lds, qr, r32, hi); partialSM(pA0, pA1, m_reg, mnA, alA);
  SLOAD(SO, KVBLK); if constexpr (SDEPTH == 2) { if (2 < NT) SLOAD(SE, 2 * KVBLK); }
  SWAIT(); SWRITE(1, SO); __syncthreads();
  for (int j = 1; j + 1 < NT; j += 2) {
    SBAR(); qkt(pB0, pB1, (bf16*)((char*)K_lds + SHM_K), qr, r32, hi);
    finishSM(pA0, pA1, alA, l_reg, pa0, pa1, pa2, pa3); SBAR();
    SLOAD(SO, (j + SDEPTH) * KVBLK); SBAR();
    pv_d0(o, vb0, pa0, pa1, pa2, pa3); partialSM(pB0, pB1, m_reg, mnB, alB);
    __syncthreads(); SWAIT(); SWRITE(0, SE);
    RESC(alB); __syncthreads();
    SBAR(); qkt(pA0, pA1, K_lds, qr, r32, hi);
    finishSM(pB0, pB1, alB, l_reg, pa0, pa1, pa2, pa3); SBAR();
    if (SDEPTH == 1 || j + 3 < NT) SLOAD(SE, (j + 1 + SDEPTH) * KVBLK); SBAR();
    pv_d0(o, vb0 + (int)SHM_V, pa0, pa1, pa2, pa3); partialSM(pA0, pA1, m_reg, mnA, alA);
    __syncthreads(); SWAIT(); SWRITE(1, SO);
    RESC(alA); __syncthreads();
  }
  SBAR(); qkt(pB0, pB1, (bf16*)((char*)K_lds + SHM_K), qr, r32, hi);
  finishSM(pA0, pA1, alA, l_reg, pa0, pa1, pa2, pa3); SBAR();
  pv_d0(o, vb0, pa0, pa1, pa2, pa3); partialSM(pB0, pB1, m_reg, mnB, alB);
  __syncthreads(); RESC(alB);
  finishSM(pB0, pB1, alB, l_reg, pa0, pa1, pa2, pa3); SBAR();
  pv_d0(o, vb0 + (int)SHM_V, pa0, pa1, pa2, pa3);
  if (hi == 0) li_l[r32] = l_reg; asm volatile("s_waitcnt lgkmcnt(0)" ::: "memory");
  float rli[16];
#pragma unroll
  for (int r = 0; r < 16; ++r) rli[r] = __builtin_amdgcn_rcpf(li_l[crow(r, hi)]);
  unsigned short* Zw = Zb + (long)(wid * QBLK) * LDZ;
#pragma unroll
  for (int r = 0; r < 16; ++r) { int orow = crow(r, hi);
#pragma unroll
    for (int d0 = 0; d0 < 4; ++d0) { unsigned short* zp = Zw + (long)orow * LDZ + d0 * 32 + r32;
      const float z = __uint_as_float(((unsigned)*zp) << 16); const float val = o[d0][r] * rli[r] * (z / (1.f + __expf(-z)));
      unsigned u = __float_as_uint(val); if (!dry) *zp = (unsigned short)((u + 0x7fffu + ((u >> 16) & 1u)) >> 16); } }
#undef SLOAD
#undef SWRITE
#undef SWAIT
#undef RESC
}
#undef KSWZ
#undef SBAR
}
namespace pg8 {
#define PG8_LAS __attribute__((address_space(3)))
typedef unsigned short bf16_t;
typedef short bf16x8 __attribute__((ext_vector_type(8)));
typedef float f32x4 __attribute__((ext_vector_type(4)));
typedef unsigned u32x4 __attribute__((ext_vector_type(4)));
constexpr int BM = 256, BK = 64, HALF = 128, HTB = HALF * BK * 2  , STAGE_BYTES = 8 * HTB, NXCD = 8, WGM = 4;

__host__ __device__ __forceinline__ int lds_byte(int r, int c) { const int st = (r >> 4) * 2 + (c >> 5), rr = r & 15, cc = c & 31, ob = rr * 64 + cc * 2; return st * 1024 + (ob ^ (((ob >> 9) & 1) << 5)); }
__host__ __device__ __forceinline__ void stage_rc(int b, int& R, int& C) { const int st = b / 1024, sb = b % 1024, swz = sb ^ (((sb >> 9) & 1) << 5); R = (st >> 1) * 16 + swz / 64; C = (st & 1) * 32 + (swz % 64) / 2; }
__host__ __device__ __forceinline__ int perm32(int rho) { const int n = rho >> 4, i = rho & 15; return 8 * (i >> 2) + 4 * n + (i & 3); }

struct Unit { int pm, pn; };
struct Gemm { const bf16_t* A; const bf16_t* Bt; int M, N, K; };

struct StaticOrder {
    int nM, nN, nwg, G, c;
    __host__ __device__ void init(int M, int N, int G_, int c_) { nM = M / BM; nN = N / BM; nwg = nM * nN; G = G_; c = c_; }
    __host__ __device__ bool next(int i, Unit& u) const {
        const long L = (long)i * G + c; if (L >= nwg) return false;
        int wgid = (int)L; { const int q = nwg / NXCD, r = nwg % NXCD, xcd = wgid % NXCD, off = wgid / NXCD; wgid = (xcd < r ? xcd * (q + 1) : r * (q + 1) + (xcd - r) * q) + off; }
        const int nig = WGM * nN, gid = wgid / nig, fm = gid * WGM, gsz = (nM - fm) < WGM ? (nM - fm) : WGM;
        u.pm = fm + ((wgid % nig) % gsz); u.pn = (wgid % nig) / gsz; return true;
    }
    __device__ __forceinline__ void a_ready(const Unit&) const {}
    __device__ __forceinline__ void done(const Unit&) const {}
};

__device__ __forceinline__ unsigned cvt_pk_bf16(float lo, float hi) { unsigned r; asm volatile("v_cvt_pk_bf16_f32 %0, %1, %2" : "=v"(r) : "v"(lo), "v"(hi)); return r; }
struct EpiP {
    static constexpr bool PERM = true, AFTER_DRAIN = false;
    unsigned char* P; int tg;
    __device__ __forceinline__ void operator()(const f32x4 (&acc)[2][2][4][2], const Unit& u, int wr, int wc, int fr, int fq) const {
        const SubInfo si = sub_info(u.pn * BM);
        bf16_t* base = (bf16_t*)(P + (size_t)si.col0 * tg * 2);
        const int lc = u.pn * BM - si.col0 + wc * 32 + 8 * fq, row0 = u.pm * BM + wr * 64 + fr;
        if (si.col0 == C_GLU) {
            const int vc = ((u.pn * BM - C_GLU) >> 8) * 128 + wc * 32 + 8 * fq;
#pragma unroll
            for (int ai = 0; ai < 2; ++ai)
#pragma unroll
                for (int m = 0; m < 4; ++m) { const f32x4 a0 = acc[ai][0][m][0], a1 = acc[ai][0][m][1], g0 = acc[ai][1][m][0], g1 = acc[ai][1][m][1];
                    u32x4 w; w.x = cvt_pk_bf16(a0[0] * sigm(g0[0]), a0[1] * sigm(g0[1])); w.y = cvt_pk_bf16(a0[2] * sigm(g0[2]), a0[3] * sigm(g0[3]));
                    w.z = cvt_pk_bf16(a1[0] * sigm(g1[0]), a1[1] * sigm(g1[1])); w.w = cvt_pk_bf16(a1[2] * sigm(g1[2]), a1[3] * sigm(g1[3]));
                    *(u32x4*)(base + (size_t)(row0 + ai * HALF + m * 16) * 512 + vc) = w; }
            return;
        }
#pragma unroll
        for (int ai = 0; ai < 2; ++ai)
#pragma unroll
            for (int m = 0; m < 4; ++m) { bf16_t* rowp = base + (size_t)(row0 + ai * HALF + m * 16) * si.width + lc;
#pragma unroll
                for (int bj = 0; bj < 2; ++bj) { const f32x4 v0 = acc[ai][bj][m][0], v1 = acc[ai][bj][m][1];
                    u32x4 w; w.x = cvt_pk_bf16(v0[0], v0[1]); w.y = cvt_pk_bf16(v0[2], v0[3]); w.z = cvt_pk_bf16(v1[0], v1[1]); w.w = cvt_pk_bf16(v1[2], v1[3]);
                    *(u32x4*)(rowp + bj * HALF) = w; } }
    }
};
struct BrOrder {
    int ntile, G, c, tpg;
    __device__ __forceinline__ bool next(int i, Unit& u) const {
        const int tile = c + (i >> 2) * G; if (tile >= ntile) return false;
        const int br = i & 3; u.pm = br * tpg + (tile >> 2); u.pn = br * 4 + (tile & 3); return true;
    }
    __device__ __forceinline__ void a_ready(const Unit&) const {}
    __device__ __forceinline__ void done(const Unit&) const {}
};
struct EpiBr {
    static constexpr bool PERM = true, AFTER_DRAIN = false;
    const bf16_t* MG; float* Macc; bf16_t* merged; int tpg;
    __device__ __forceinline__ void operator()(const f32x4 (&acc)[2][2][4][2], const Unit& u, int wr, int wc, int fr, int fq) const {
        const int br = u.pn >> 2, pn = u.pn & 3, pm = u.pm - br * tpg;
        const int row0 = pm * BM + wr * 64 + fr, col0 = pn * BM + wc * 32 + 8 * fq;
#pragma unroll
        for (int ai = 0; ai < 2; ++ai)
#pragma unroll
            for (int m = 0; m < 4; ++m) { const size_t row = (size_t)(row0 + ai * HALF + m * 16);
#pragma unroll
                for (int bj = 0; bj < 2; ++bj) { const int col = col0 + bj * HALF;
                    const u32x4 gw = *(const u32x4*)(MG + row * 4096 + br * 1024 + col);
                    f32x4 v0 = acc[ai][bj][m][0], v1 = acc[ai][bj][m][1];
                    v0[0] *= sigm(bf2f(gw.x & 0xffffu)); v0[1] *= sigm(bf2f(gw.x >> 16)); v0[2] *= sigm(bf2f(gw.y & 0xffffu)); v0[3] *= sigm(bf2f(gw.y >> 16));
                    v1[0] *= sigm(bf2f(gw.z & 0xffffu)); v1[1] *= sigm(bf2f(gw.z >> 16)); v1[2] *= sigm(bf2f(gw.w & 0xffffu)); v1[3] *= sigm(bf2f(gw.w >> 16));
                    bf16_t* mp = (bf16_t*)Macc + row * 1024 + col;
                    if (br > 0) { const u32x4 pw = *(const u32x4*)mp;
                        v0[0] += bf2f(pw.x & 0xffffu); v0[1] += bf2f(pw.x >> 16); v0[2] += bf2f(pw.y & 0xffffu); v0[3] += bf2f(pw.y >> 16);
                        v1[0] += bf2f(pw.z & 0xffffu); v1[1] += bf2f(pw.z >> 16); v1[2] += bf2f(pw.w & 0xffffu); v1[3] += bf2f(pw.w >> 16); }
                    { u32x4 w; w.x = cvt_pk_bf16(v0[0], v0[1]); w.y = cvt_pk_bf16(v0[2], v0[3]); w.z = cvt_pk_bf16(v1[0], v1[1]); w.w = cvt_pk_bf16(v1[2], v1[3]);
                        if (br < 3) *(u32x4*)mp = w; else
                        *(u32x4*)(merged + row * 1024 + col) = w; } } }
    }
};
struct BrOrder2 {
    int ntile, G, c, tpg; bool skipctx;
    __device__ __forceinline__ bool next(int i, Unit& u) const {
        const int L = i * G + c; if (L >= 4 * ntile) return false;
        const int br = L / ntile, t = L - br * ntile; int pm = t >> 2; if (skipctx) pm = (pm >> 3) * 9 + 1 + (pm & 7);
        u.pm = br * tpg + pm; u.pn = br * 4 + (t & 3); return true;
    }
    __device__ __forceinline__ void a_ready(const Unit&) const {}
    __device__ __forceinline__ void done(const Unit&) const {}
};
struct EpiBr2 {
    static constexpr bool PERM = true, AFTER_DRAIN = false;
    const bf16_t* MG; bf16_t* Gb; int tpg; size_t gstride;
    __device__ __forceinline__ void operator()(const f32x4 (&acc)[2][2][4][2], const Unit& u, int wr, int wc, int fr, int fq) const {
        const int br = u.pn >> 2, pn = u.pn & 3, pm = u.pm - br * tpg;
        const int row0 = pm * BM + wr * 64 + fr, col0 = pn * BM + wc * 32 + 8 * fq;
        bf16_t* Go = Gb + (size_t)br * gstride;
#pragma unroll
        for (int ai = 0; ai < 2; ++ai)
#pragma unroll
            for (int m = 0; m < 4; ++m) { const size_t row = (size_t)(row0 + ai * HALF + m * 16);
                u32x4 gw[2];
#pragma unroll
                for (int bj = 0; bj < 2; ++bj) gw[bj] = *(const u32x4*)(MG + row * 4096 + br * 1024 + col0 + bj * HALF);
#pragma unroll
                for (int bj = 0; bj < 2; ++bj) { const int col = col0 + bj * HALF;
                    f32x4 v0 = acc[ai][bj][m][0], v1 = acc[ai][bj][m][1];
                    v0[0] *= sigm(bf2f(gw[bj].x & 0xffffu)); v0[1] *= sigm(bf2f(gw[bj].x >> 16)); v0[2] *= sigm(bf2f(gw[bj].y & 0xffffu)); v0[3] *= sigm(bf2f(gw[bj].y >> 16));
                    v1[0] *= sigm(bf2f(gw[bj].z & 0xffffu)); v1[1] *= sigm(bf2f(gw[bj].z >> 16)); v1[2] *= sigm(bf2f(gw[bj].w & 0xffffu)); v1[3] *= sigm(bf2f(gw[bj].w >> 16));
                    u32x4 w; w.x = cvt_pk_bf16(v0[0], v0[1]); w.y = cvt_pk_bf16(v0[2], v0[3]); w.z = cvt_pk_bf16(v1[0], v1[1]); w.w = cvt_pk_bf16(v1[2], v1[3]);
                    *(u32x4*)(Go + row * 1024 + col) = w; } }
    }
};
struct EpiOut {
    static constexpr bool PERM = true, AFTER_DRAIN = false;
    Params p; float* hpre; int l, g;
    __device__ __forceinline__ void operator()(const f32x4 (&acc)[2][2][4][2], const Unit& u, int wr, int wc, int fr, int fq) const {
        const int row0 = u.pm * BM + wr * 64 + fr, col0 = u.pn * BM + wc * 32 + 8 * fq;
        const float* mod = (const float*)(p.ws + WS_MOD);
#pragma unroll
        for (int ai = 0; ai < 2; ++ai)
#pragma unroll
            for (int m = 0; m < 4; ++m) { const int row = row0 + ai * HALF + m * 16, grow = g * p.tg + row, b = grow / TPB, s = grow % TPB;
                const float* hr = h_in_row(p, l, grow); const float* gt = mod + ((size_t)l * 9 + (s < CTX ? 8 : b)) * 3072 + 2048;
#pragma unroll
                for (int bj = 0; bj < 2; ++bj) { const int col = col0 + bj * HALF;
                    const f32x4 h0 = *(const f32x4*)(hr + col), h1 = *(const f32x4*)(hr + col + 4), g0 = *(const f32x4*)(gt + col), g1 = *(const f32x4*)(gt + col + 4);
                    float* op = hpre + (size_t)row * 1024 + col;
                    *(f32x4*)op = h0 * ALPHA + g0 * acc[ai][bj][m][0]; *(f32x4*)(op + 4) = h1 * ALPHA + g1 * acc[ai][bj][m][1]; } }
    }
};
template <class Epi, class Sched, bool ALIGN_EPI = false, bool SP2 = false>
__device__ __forceinline__ void gemm_phase(PG8_LAS unsigned char* lds, const Gemm g, const Sched& S, const Epi& E) {
    const int tid = otid(), wid = __builtin_amdgcn_readfirstlane(tid >> 6), lane = tid & 63, wr = wid >> 2, wc = wid & 3, fr = lane & 15, fq = lane >> 4;
    const int K = g.K, nt = K / BK;
    unsigned voffA[2], voffB[2];
#pragma unroll
    for (int i = 0; i < 2; ++i) { int R, C; stage_rc(tid * 16 + i * 8192, R, C); const int Rb = Epi::PERM ? ((R & ~31) + perm32(R & 31)) : R;
        voffA[i] = (unsigned)(R * K + C) * 2u; voffB[i] = (unsigned)(Rb * K + C) * 2u; }
    const size_t kstep = (size_t)(BK * 2);
    const size_t hstep = (size_t)HALF * K * 2;
    const size_t tstep = 2 * hstep;
    const unsigned ldsw = (unsigned)wid * 1024u;
    const int aoff = lds_byte(wr * 64 + fr, fq * 8), boff = lds_byte(wc * 32 + fr, fq * 8);
#define PG8_SA(b, h) (((b) * 2 + (h)) * HTB)
#define PG8_SB(b, h) ((4 + (b) * 2 + (h)) * HTB)
#define PG8_STAGE(bufoff, gbase, voff) do { _Pragma("unroll") for (int _i = 0; _i < 2; ++_i) \
        __builtin_amdgcn_global_load_lds((const unsigned*)((const char*)(gbase) + (voff)[_i]), (PG8_LAS unsigned*)(lds + (bufoff) + ldsw + _i * 8192), 16, 0, 0); } while (0)
#define PG8_LDA(dst, b, h) do { _Pragma("unroll") for (int m = 0; m < 4; ++m) _Pragma("unroll") for (int k = 0; k < 2; ++k) dst[m][k] = *(const PG8_LAS bf16x8*)(lds + PG8_SA(b, h) + aoff + m * 2048 + k * 1024); } while (0)
#define PG8_LDB(dst, b, h) do { _Pragma("unroll") for (int n = 0; n < 2; ++n) _Pragma("unroll") for (int k = 0; k < 2; ++k) dst[n][k] = *(const PG8_LAS bf16x8*)(lds + PG8_SB(b, h) + boff + n * 2048 + k * 1024); } while (0)
#define PG8_MMA(ai, bj, At, Bt) do { __builtin_amdgcn_s_setprio(1); _Pragma("unroll") for (int m = 0; m < 4; ++m) _Pragma("unroll") for (int n = 0; n < 2; ++n) _Pragma("unroll") for (int k = 0; k < 2; ++k) \
        acc[ai][bj][m][n] = __builtin_amdgcn_mfma_f32_16x16x32_bf16(Bt[n][k], At[m][k], acc[ai][bj][m][n], 0, 0, 0); __builtin_amdgcn_s_setprio(0); } while (0)
#define PG8_WAIT_V(n) asm volatile("s_waitcnt vmcnt(" #n ")" ::: "memory")
#define PG8_WAIT_L(n) asm volatile("s_waitcnt lgkmcnt(" #n ")" ::: "memory")
#define PG8_BAR __builtin_amdgcn_s_barrier()
#define PG8_SCHED __builtin_amdgcn_sched_barrier(0)
    Unit cur, nxt; int ui = 0;
    if (!S.next(0, cur)) return;
    f32x4 acc[2][2][4][2];
#pragma unroll
    for (int a = 0; a < 2; ++a)
#pragma unroll
        for (int b = 0; b < 2; ++b)
#pragma unroll
            for (int m = 0; m < 4; ++m)
#pragma unroll
                for (int n = 0; n < 2; ++n) acc[a][b][m][n] = (f32x4){0.f, 0.f, 0.f, 0.f};
    bf16x8 At[4][2], B0[2][2], B1[2][2];
    const char* cA = (const char*)g.A + (size_t)cur.pm * tstep; const char* cB = (const char*)g.Bt + (size_t)cur.pn * tstep;
    S.a_ready(cur);
    if constexpr (SP2) {
        PG8_STAGE(PG8_SB(0, 0), cB, voffB); PG8_STAGE(PG8_SB(0, 1), cB + hstep, voffB); PG8_STAGE(PG8_SA(0, 0), cA, voffA); PG8_STAGE(PG8_SA(0, 1), cA + hstep, voffA);
        if (wr == 1) PG8_BAR;
        PG8_WAIT_V(2); PG8_BAR;
        PG8_STAGE(PG8_SB(1, 0), cB + kstep, voffB); PG8_STAGE(PG8_SA(1, 0), cA + kstep, voffA); PG8_STAGE(PG8_SB(1, 1), cB + hstep + kstep, voffB);
        PG8_WAIT_V(6); PG8_BAR;
    } else {
        PG8_STAGE(PG8_SB(0, 0), cB, voffB); PG8_STAGE(PG8_SA(0, 0), cA, voffA); PG8_STAGE(PG8_SB(0, 1), cB + hstep, voffB); PG8_STAGE(PG8_SA(0, 1), cA + hstep, voffA);
        if (wr == 1) PG8_BAR;
        PG8_WAIT_V(4); PG8_BAR;
        PG8_STAGE(PG8_SB(1, 0), cB + kstep, voffB); PG8_STAGE(PG8_SA(1, 0), cA + kstep, voffA); PG8_STAGE(PG8_SB(1, 1), cB + hstep + kstep, voffB);
        PG8_WAIT_V(6); PG8_BAR;
    }
    for (;;) {
        const bool has_next = S.next(ui + 1, nxt);
        const char* nA = has_next ? (const char*)g.A + (size_t)nxt.pm * tstep : cA; const char* nB = has_next ? (const char*)g.Bt + (size_t)nxt.pn * tstep : cB;
        for (int t = 0; t < nt; t += 2) {
            const bool last = (t == nt - 2);
            const char* a1 = cA + (size_t)(t + 1) * kstep;
            const char* a2 = last ? nA : cA + (size_t)(t + 2) * kstep; const char* b2 = last ? nB : cB + (size_t)(t + 2) * kstep;
            const char* a3 = a2 + kstep; const char* b3 = b2 + kstep;
            if (last && has_next) S.a_ready(nxt);
            if constexpr (SP2) {
            PG8_LDB(B0, 0, 0); PG8_LDB(B1, 0, 1); PG8_SCHED; PG8_LDA(At, 0, 0); PG8_STAGE(PG8_SA(1, 1), a1 + hstep, voffA);
            PG8_WAIT_V(8); PG8_WAIT_L(0); PG8_BAR; PG8_MMA(0, 0, At, B0); PG8_MMA(0, 1, At, B1); PG8_BAR; PG8_SCHED;
            PG8_LDA(At, 0, 1); PG8_STAGE(PG8_SB(0, 0), b2, voffB); PG8_STAGE(PG8_SB(0, 1), b2 + hstep, voffB); PG8_STAGE(PG8_SA(0, 0), a2, voffA);
            PG8_WAIT_V(8); PG8_WAIT_L(0); PG8_BAR; PG8_MMA(1, 0, At, B0); PG8_MMA(1, 1, At, B1); PG8_BAR; PG8_SCHED;
            PG8_LDB(B0, 1, 0); PG8_LDB(B1, 1, 1); PG8_SCHED; PG8_LDA(At, 1, 0); PG8_STAGE(PG8_SA(0, 1), a2 + hstep, voffA);
            PG8_WAIT_V(8); PG8_WAIT_L(0); PG8_BAR; PG8_MMA(0, 0, At, B0); PG8_MMA(0, 1, At, B1); PG8_BAR; PG8_SCHED;
            PG8_LDA(At, 1, 1); PG8_STAGE(PG8_SB(1, 0), b3, voffB); PG8_STAGE(PG8_SB(1, 1), b3 + hstep, voffB); PG8_STAGE(PG8_SA(1, 0), a3, voffA);
            PG8_WAIT_V(8); PG8_WAIT_L(0); PG8_BAR; PG8_MMA(1, 0, At, B0); PG8_MMA(1, 1, At, B1); PG8_BAR; PG8_SCHED;
            } else {
            PG8_LDB(B0, 0, 0); PG8_SCHED; PG8_LDA(At, 0, 0); PG8_STAGE(PG8_SA(1, 1), a1 + hstep, voffA);
            PG8_WAIT_L(8); PG8_BAR; PG8_WAIT_L(0); PG8_MMA(0, 0, At, B0); PG8_BAR; PG8_SCHED;
            PG8_LDB(B1, 0, 1); PG8_STAGE(PG8_SB(0, 0), b2, voffB);
            PG8_BAR; PG8_WAIT_L(0); PG8_MMA(0, 1, At, B1); PG8_BAR;
            PG8_LDA(At, 0, 1); PG8_STAGE(PG8_SA(0, 0), a2, voffA);
            PG8_BAR; PG8_WAIT_L(0); PG8_MMA(1, 0, At, B0); PG8_BAR; PG8_SCHED;
            PG8_STAGE(PG8_SB(0, 1), b2 + hstep, voffB);
            PG8_WAIT_V(6); PG8_BAR; PG8_MMA(1, 1, At, B1); PG8_BAR;
            PG8_LDB(B0, 1, 0); PG8_SCHED; PG8_LDA(At, 1, 0); PG8_STAGE(PG8_SA(0, 1), a2 + hstep, voffA);
            PG8_WAIT_L(8); PG8_BAR; PG8_WAIT_L(0); PG8_MMA(0, 0, At, B0); PG8_BAR; PG8_SCHED;
            PG8_LDB(B1, 1, 1); PG8_STAGE(PG8_SB(1, 0), b3, voffB);
            PG8_BAR; PG8_WAIT_L(0); PG8_MMA(0, 1, At, B1); PG8_BAR;
            PG8_LDA(At, 1, 1); PG8_STAGE(PG8_SA(1, 0), a3, voffA);
            PG8_BAR; PG8_WAIT_L(0); PG8_MMA(1, 0, At, B0); PG8_BAR; PG8_SCHED;
            PG8_STAGE(PG8_SB(1, 1), b3 + hstep, voffB);
            PG8_WAIT_V(6); PG8_BAR; PG8_MMA(1, 1, At, B1); PG8_BAR;
            }
        }
        if constexpr (ALIGN_EPI) { if (wr == 0) PG8_BAR; }
        if constexpr (!Epi::AFTER_DRAIN) { E(acc, cur, wr, wc, fr, fq); S.done(cur); }
        if (!has_next) break;
#pragma unroll
        for (int a = 0; a < 2; ++a)
#pragma unroll
            for (int b = 0; b < 2; ++b)
#pragma unroll
                for (int m = 0; m < 4; ++m)
#pragma unroll
                    for (int n = 0; n < 2; ++n) acc[a][b][m][n] = (f32x4){0.f, 0.f, 0.f, 0.f};
        cur = nxt; cA = nA; cB = nB; ++ui;
        if constexpr (ALIGN_EPI) { if (wr == 1) PG8_BAR; }
    }
    PG8_WAIT_V(0);
    if constexpr (!ALIGN_EPI) { if (wr == 0) PG8_BAR; }
    PG8_BAR;
    if constexpr (Epi::AFTER_DRAIN) { E.fused(acc, cur, wr, wc, fr, fq, lds, wid, lane); S.done(cur); }
#undef PG8_SA
#undef PG8_SB
#undef PG8_STAGE
#undef PG8_LDA
#undef PG8_LDB
#undef PG8_MMA
#undef PG8_WAIT_V
#undef PG8_WAIT_L
#undef PG8_BAR
#undef PG8_SCHED
}
}
__device__ __forceinline__ void mod_item(const Params& p, int item, unsigned char* lds) {
    const int l = item / 48, cb = item % 48, t = otid(), lane = t & 63, w = t >> 6;
    float* sc = (float*)lds; float* red = sc + 9 * 1024;
    for (int i = t; i < 9 * 1024; i += 512) { const int b = i >> 10, k = i & 1023; const float v = b < 8 ? p.c[b * 1024 + k] : p.c_ctx[k]; sc[i] = silu(v); }
    __syncthreads();
    const float* wm = p.w_mod + (size_t)l * 1024 * 3072 + cb * 64 + lane;
    float acc[9];
#pragma unroll
    for (int b = 0; b < 9; ++b) acc[b] = 0.f;
#pragma unroll 16
    for (int k = w * 128; k < w * 128 + 128; ++k) { const float wv = wm[(size_t)k * 3072];
#pragma unroll
        for (int b = 0; b < 9; ++b) acc[b] += sc[b * 1024 + k] * wv; }
#pragma unroll
    for (int b = 0; b < 9; ++b) red[(w * 9 + b) * 64 + lane] = acc[b];
    __syncthreads();
    float* mod = (float*)(p.ws + WS_MOD);
    for (int i = t; i < 576; i += 512) { const int b = i >> 6, c = i & 63; float s = 0.f;
#pragma unroll
        for (int w2 = 0; w2 < 8; ++w2) s += red[(w2 * 9 + b) * 64 + c];
        mod[((size_t)l * 9 + b) * 3072 + cb * 64 + c] = s + p.b_mod[l * 3072 + cb * 64 + c]; }
    __syncthreads();
}
struct TJob { const float* src; bf16_t* dst; int spitch, dpitch, nvalid; };
__device__ __forceinline__ TJob tjob(const Params& p, int it) {
    constexpr int N_WIN = 2 * 168 * 16, N_R = 32, N_BR = 1024;
    bf16_t* Win_t = (bf16_t*)(p.ws + WS_WIN); bf16_t* Wr_t = (bf16_t*)(p.ws + WS_WR); bf16_t* Wbr_t = (bf16_t*)(p.ws + WS_WBR); bf16_t* Wout_t = (bf16_t*)(p.ws + WS_WOUT);
    TJob j;
    if (it < N_WIN) { const int l = it / 2688, rem = it % 2688, nt = rem / 16, kt = rem % 16, n0 = nt * 64; const SubInfo si = sub_info(n0);
        int oc = si.orig0 + (n0 - si.col0);
        if (si.col0 == C_GLU) { const int jj = n0 - C_GLU; oc = si.orig0 + ((jj & 255) >> 7) * 512 + (jj >> 8) * 128 + (jj & 127); }
        j.src = p.w_in + (size_t)l * 1024 * WIN_COLS + (size_t)(kt * 64) * WIN_COLS + oc; j.spitch = WIN_COLS; j.nvalid = 64;
        j.dst = Win_t + (size_t)l * NCOL * 1024 + (size_t)n0 * 1024 + kt * 64; j.dpitch = 1024; return j; }
    it -= N_WIN;
    if (it < N_R) { const int l = it / 16, kt = it % 16;
        j.src = p.w_in + (size_t)l * 1024 * WIN_COLS + (size_t)(kt * 64) * WIN_COLS + 5120; j.spitch = WIN_COLS; j.nvalid = 32; j.dst = Wr_t + (size_t)l * 32 * 1024 + kt * 64; j.dpitch = 1024; return j; }
    it -= N_R;
    if (it < N_BR) { const int li = it / 128, rem = it % 128, kt = rem / 16, nt = rem % 16;
        j.src = p.w_br + ((size_t)li * 512 + kt * 64) * 1024 + nt * 64; j.spitch = 1024; j.nvalid = 64; j.dst = Wbr_t + ((size_t)li * 1024 + nt * 64) * 512 + kt * 64; j.dpitch = 512; return j; }
    it -= N_BR;
    { const int l = it / 256, rem = it % 256, kt = rem / 16, nt = rem % 16;
        j.src = p.w_out + ((size_t)l * 1024 + kt * 64) * 1024 + nt * 64; j.spitch = 1024; j.nvalid = 64; j.dst = Wout_t + ((size_t)l * 1024 + nt * 64) * 1024 + kt * 64; j.dpitch = 1024; return j; }
}
__device__ __forceinline__ int tjob_global(int l, int j) {
    if (j < 2688) return l * 2688 + j;
    if (j < 2704) return 5376 + l * 16 + (j - 2688);
    if (j < 3216) return 5408 + l * 512 + (j - 2704);
    return 6432 + l * 256 + (j - 3216);
}
__device__ __forceinline__ void weight_prep(const Params& p, int l, int j0, int j1, int b0, unsigned char* lds) {
    const int nblk = (int)gridDim.x - b0, bid = (int)blockIdx.x - b0;
    if (bid < 0) return;
    float* tile = (float*)lds;
    const int t = otid(), r = t >> 3, c8 = (t & 7) * 8;
    int it = j0 + bid, buf = 0;
    f32x4 a = {0.f, 0.f, 0.f, 0.f}, b = {0.f, 0.f, 0.f, 0.f};
    TJob cur = tjob(p, tjob_global(l, it < j1 ? it : j0));
    if (it < j1 && c8 < cur.nvalid) { a = *(const f32x4*)(cur.src + (size_t)r * cur.spitch + c8); b = *(const f32x4*)(cur.src + (size_t)r * cur.spitch + c8 + 4); }
    for (; it < j1; it += nblk) {
        const int nit = it + nblk; f32x4 na = {0.f, 0.f, 0.f, 0.f}, nb = {0.f, 0.f, 0.f, 0.f};
        TJob nxt = tjob(p, tjob_global(l, nit < j1 ? nit : j0));
        if (nit < j1 && c8 < nxt.nvalid) { na = *(const f32x4*)(nxt.src + (size_t)r * nxt.spitch + c8); nb = *(const f32x4*)(nxt.src + (size_t)r * nxt.spitch + c8 + 4); }
        float* tb = tile + buf * (64 * 65);
        { float* tp = tb + r * 65 + c8; tp[0] = a[0]; tp[1] = a[1]; tp[2] = a[2]; tp[3] = a[3]; tp[4] = b[0]; tp[5] = b[1]; tp[6] = b[2]; tp[7] = b[3]; }
        __syncthreads();
        if (r < cur.nvalid) { u32x4 w;
            w.x = pk2(tb[(c8 + 0) * 65 + r], tb[(c8 + 1) * 65 + r]); w.y = pk2(tb[(c8 + 2) * 65 + r], tb[(c8 + 3) * 65 + r]);
            w.z = pk2(tb[(c8 + 4) * 65 + r], tb[(c8 + 5) * 65 + r]); w.w = pk2(tb[(c8 + 6) * 65 + r], tb[(c8 + 7) * 65 + r]);
            *(u32x4*)(cur.dst + (size_t)r * cur.dpitch + c8) = w; }
        cur = nxt; a = na; b = nb; buf ^= 1;
    }
    __syncthreads();
}
__device__ __forceinline__ void phase0(const Params& p, unsigned char* lds, bool defer_l1) {
    constexpr int N_MOD = 96;
    const int G = gridDim.x, bid = blockIdx.x;
    if (bid >= G - N_MOD || G < N_MOD) { for (int it = (G < N_MOD ? bid : bid - (G - N_MOD)); it < N_MOD; it += (G < N_MOD ? G : N_MOD)) mod_item(p, it, lds); }
    weight_prep(p, 0, 0, 3472, 0, lds);
    if (!defer_l1) weight_prep(p, 1, 0, 3472, 0, lds);
}

__device__ __forceinline__ void ln_phase(const Params& p, int mode, int l, int lu, int row0, int nrows, const float* __restrict__ hpre) {
    const int tid_ = otid(), lane = tid_ & 63, w = tid_ >> 6;
    const float* mod = (const float*)(p.ws + WS_MOD); bf16_t* U = (bf16_t*)(p.ws + WS_U); float* hctx = (float*)(p.ws + WS_HCTX);
    const int neff = mode == 2 ? (nrows / TPB) * SEQ : nrows, stride = gridDim.x * 8;
#define LN_ROW(i) (mode == 2 ? ((i) / SEQ) * TPB + CTX + (i) % SEQ : (i))
#define LN_SRC(rr) (mode == 0 ? h_in_row(p, 0, row0 + (rr)) : hpre + (size_t)(rr) * 1024)
    int ie = blockIdx.x * 8 + w;
    f32x4 nv[4];
#pragma unroll
    for (int q = 0; q < 4; ++q) nv[q] = (f32x4){0.f, 0.f, 0.f, 0.f};
    if (ie < neff) { const float* src = LN_SRC(LN_ROW(ie));
#pragma unroll
        for (int q = 0; q < 4; ++q) nv[q] = *(const f32x4*)(src + q * 256 + lane * 4); }
    for (; ie < neff; ie += stride) {
        const int rr = LN_ROW(ie), grow = row0 + rr, b = grow / TPB, s = grow % TPB; const bool isctx = s < CTX;
        f32x4 v[4];
#pragma unroll
        for (int q = 0; q < 4; ++q) v[q] = nv[q];
        if (ie + stride < neff) { const float* src = LN_SRC(LN_ROW(ie + stride));
#pragma unroll
            for (int q = 0; q < 4; ++q) nv[q] = *(const f32x4*)(src + q * 256 + lane * 4); }
        float s1 = 0.f;
#pragma unroll
        for (int q = 0; q < 4; ++q) s1 += (v[q][0] + v[q][1]) + (v[q][2] + v[q][3]);
        float mean = wave_sum(s1) * (1.f / 1024.f), s2 = 0.f;
#pragma unroll
        for (int q = 0; q < 4; ++q) { const f32x4 d = v[q] - mean; s2 += (d[0] * d[0] + d[1] * d[1]) + (d[2] * d[2] + d[3] * d[3]); }
        float rstd = rsqrtf(wave_sum(s2) * (1.f / 1024.f) + EPS);
        if (mode != 0) {
            float* hdst = isctx ? hctx + ((size_t)b * CTX + s) * 1024 : p.out + ((size_t)b * SEQ + (s - CTX)) * 1024;
#pragma unroll
            for (int q = 0; q < 4; ++q) { const int col = q * 256 + lane * 4;
                const f32x4 gg = *(const f32x4*)(p.ln_g + l * 1024 + col), bb = *(const f32x4*)(p.ln_b + l * 1024 + col);
                v[q] = (v[q] - mean) * rstd * gg + bb; *(f32x4*)(hdst + col) = v[q]; }
            if (mode == 2) continue;
            s1 = 0.f;
#pragma unroll
            for (int q = 0; q < 4; ++q) s1 += (v[q][0] + v[q][1]) + (v[q][2] + v[q][3]);
            mean = wave_sum(s1) * (1.f / 1024.f); s2 = 0.f;
#pragma unroll
            for (int q = 0; q < 4; ++q) { const f32x4 d = v[q] - mean; s2 += (d[0] * d[0] + d[1] * d[1]) + (d[2] * d[2] + d[3] * d[3]); }
            rstd = rsqrtf(wave_sum(s2) * (1.f / 1024.f) + EPS);
        }
        const float* md = mod + ((size_t)lu * 9 + (isctx ? 8 : b)) * 3072;
#pragma unroll
        for (int q = 0; q < 4; ++q) { const int col = q * 256 + lane * 4;
            const f32x4 sh = *(const f32x4*)(md + col), scl = *(const f32x4*)(md + 1024 + col);
            const f32x4 uu = (v[q] - mean) * rstd * (scl + 1.f) + sh;
            uint2 o; o.x = pk2(uu[0], uu[1]); o.y = pk2(uu[2], uu[3]);
            *(uint2*)(U + (size_t)grow * 1024 + col) = o; }
    }
#undef LN_ROW
#undef LN_SRC
}

__device__ __forceinline__ void r_items(const Params& p, int l, int g, unsigned char* lds, int b0 = 0) {
    const int tid_ = otid(), lane = tid_ & 63, w = tid_ >> 6, fr = lane & 15, fq = lane >> 4, tg = p.tg, nit = tg / 16;
    const int rbid = (int)blockIdx.x - b0, rnb = (int)gridDim.x - b0;
    if (rbid < 0 || rbid * 8 >= nit) return;
    const bf16_t* U = (const bf16_t*)(p.ws + WS_U) + (size_t)g * tg * 1024; float* R = (float*)(p.ws + WS_R) + (size_t)g * tg * 32;
    const bf16_t* W = (const bf16_t*)(p.ws + WS_WR) + (size_t)l * 32 * 1024;
    bf16_t* wl = (bf16_t*)lds;
    for (int i = tid_; i < 4096; i += 512) { const int n = i >> 7, k8 = (i & 127) * 8; *(u32x4*)(wl + n * 1032 + k8) = *(const u32x4*)(W + (size_t)n * 1024 + k8); }
    __syncthreads();
    for (int it = rbid * 8 + w; it < nit; it += rnb * 8) {
        f32x4 a0 = {0.f, 0.f, 0.f, 0.f}, a1 = {0.f, 0.f, 0.f, 0.f};
        const bf16_t* up = U + (size_t)(it * 16 + fr) * 1024 + fq * 8;
#pragma unroll 1
        for (int kh = 0; kh < 2; ++kh) {
            bf16x8 av[16];
#pragma unroll
            for (int ks = 0; ks < 16; ++ks) av[ks] = *(const bf16x8*)(up + (kh * 16 + ks) * 32);
#pragma unroll
            for (int ks = 0; ks < 16; ++ks) { const int ko = (kh * 16 + ks) * 32 + fq * 8;
                const bf16x8 b0 = *(const bf16x8*)(wl + fr * 1032 + ko), b1 = *(const bf16x8*)(wl + (16 + fr) * 1032 + ko);
                a0 = __builtin_amdgcn_mfma_f32_16x16x32_bf16(av[ks], b0, a0, 0, 0, 0); a1 = __builtin_amdgcn_mfma_f32_16x16x32_bf16(av[ks], b1, a1, 0, 0, 0); }
        }
#pragma unroll
        for (int jj = 0; jj < 4; ++jj) { float* rp = R + (size_t)(it * 16 + fq * 4 + jj) * 32; rp[fr] = a0[jj]; rp[16 + fr] = a1[jj]; }
    }
    __syncthreads();
}
__device__ __forceinline__ void qk_prep(const Params& p, int l, bool dry = false) {
    const int tid_ = otid(), lane = tid_ & 63, w = tid_ >> 6, tg = p.tg;
    bf16_t* Aq = subbuf(p, C_AQ); bf16_t* Ak = subbuf(p, C_AK);
    const float qg0 = p.q_norm[l * 128 + 2 * lane], qg1 = p.q_norm[l * 128 + 2 * lane + 1], kg0 = p.k_norm[l * 128 + 2 * lane], kg1 = p.k_norm[l * 128 + 2 * lane + 1];
    const float inv = exp2f(-(float)(lane & 31) * (13.287712379549449f / 32.f)) * 0.15915494309189535f;
    for (int row = blockIdx.x * 8 + w; row < tg; row += gridDim.x * 8) {
        const int s = row % TPB; float cs = 1.f, sn = 0.f;
        if (s >= CTX) { const int t = s - CTX; const int pos = lane < 32 ? (t >> 6) : (t & 63); float rev = (float)pos * inv; rev -= floorf(rev);
            sn = __builtin_amdgcn_sinf(rev); cs = __builtin_amdgcn_cosf(rev); }
        unsigned pr[6];
#pragma unroll
        for (int hh = 0; hh < 6; ++hh) { const bf16_t* ptr = hh < 4 ? Aq + (size_t)row * 512 + hh * 128 + 2 * lane : Ak + (size_t)row * 256 + (hh - 4) * 128 + 2 * lane; pr[hh] = *(const unsigned*)ptr; }
#pragma unroll
        for (int hh = 0; hh < 6; ++hh) {
            bf16_t* ptr = hh < 4 ? Aq + (size_t)row * 512 + hh * 128 + 2 * lane : Ak + (size_t)row * 256 + (hh - 4) * 128 + 2 * lane;
            const float x0 = bf2f(pr[hh] & 0xffffu), x1 = bf2f(pr[hh] >> 16);
            const float ss = wave_sum(x0 * x0 + x1 * x1), rinv = rsqrtf(ss * (1.f / 128.f) + EPS);
            const float y0 = x0 * rinv * (hh < 4 ? qg0 : kg0), y1 = x1 * rinv * (hh < 4 ? qg1 : kg1);
            if (!dry) *(unsigned*)ptr = pk2(y0 * cs - y1 * sn, y0 * sn + y1 * cs);
        }
    }
}
__device__ __forceinline__ void short_conv(const Params& p, int l, bool dry = false) {
    const int tg = p.tg; const bf16_t* Bg = subbuf(p, C_BG); const bf16_t* Cg = subbuf(p, C_CG); const bf16_t* Xin = subbuf(p, C_XIN); bf16_t* Zb = subbuf(p, C_ZB);
    const float* wv = p.b_conv + l * 3 * 512;
    const int tid_ = otid();
    for (int idx = blockIdx.x * 512 + tid_; idx < tg * 64; idx += gridDim.x * 512) {
        const int row = idx >> 6, c8 = (idx & 63) * 8, s = row % TPB; const size_t o = (size_t)row * 512 + c8;
        const bool hp = (s != 0 && s != CTX), hn = (s != CTX - 1 && s != TPB - 1);
        const u32x4 zero = {0u, 0u, 0u, 0u};
        const u32x4 bg = *(const u32x4*)(Bg + o), zb = *(const u32x4*)(Zb + o), c1 = *(const u32x4*)(Cg + o), x1 = *(const u32x4*)(Xin + o);
        const u32x4 c0 = hp ? *(const u32x4*)(Cg + o - 512) : zero, x0 = hp ? *(const u32x4*)(Xin + o - 512) : zero;
        const u32x4 c2 = hn ? *(const u32x4*)(Cg + o + 512) : zero, x2 = hn ? *(const u32x4*)(Xin + o + 512) : zero;
        u32x4 ow;
#pragma unroll
        for (int e = 0; e < 4; ++e) {
            float res[2];
#pragma unroll
            for (int hl = 0; hl < 2; ++hl) { const int c = c8 + 2 * e + hl; const int sh = hl * 16;
                const float p0 = bf2f((c0[e] >> sh) & 0xffffu) * bf2f((x0[e] >> sh) & 0xffffu), p1 = bf2f((c1[e] >> sh) & 0xffffu) * bf2f((x1[e] >> sh) & 0xffffu),
                            p2 = bf2f((c2[e] >> sh) & 0xffffu) * bf2f((x2[e] >> sh) & 0xffffu);
                const float cv = wv[c] * p0 + wv[512 + c] * p1 + wv[1024 + c] * p2;
                res[hl] = bf2f((bg[e] >> sh) & 0xffffu) * cv * silu(bf2f((zb[e] >> sh) & 0xffffu)); }
            ow[e] = pk2(res[0], res[1]);
        }
        if (!dry) *(u32x4*)(Zb + o) = ow;
    }
}
__device__ __forceinline__ void conformer(const Params& p, int l, unsigned char* lds, bool dry = false, bool skipctx = false) {
    const int tg = p.tg, c = otid(), lane = c & 63, w = c >> 6;
    float* hbuf = (float*)lds;
    bf16_t* vt = (bf16_t*)(lds + 32768);
    const bf16_t* Glu = subbuf(p, C_GLU); bf16_t* Zd = subbuf(p, C_ZD);
    float wk[31];
#pragma unroll
    for (int k = 0; k < 31; ++k) wk[k] = p.d_conv_w[((size_t)l * 31 + k) * 512 + c];
    const float bias = p.d_conv_b[l * 512 + c];
    const int nit = skipctx ? (tg / TPB) * (SEQ / 16) : tg / 16;
    for (int it_ = blockIdx.x; it_ < nit; it_ += gridDim.x) {
        const int it = skipctx ? (it_ >> 7) * 144 + 16 + (it_ & 127) : it_;
        const int r0 = it * 16, s0 = r0 % TPB, bstart = r0 - s0;
        const int seg_lo = s0 < CTX ? bstart : bstart + CTX, seg_hi = s0 < CTX ? bstart + CTX : bstart + TPB;
#pragma unroll
        for (int k6 = 0; k6 < 6; ++k6) { const int idx = c + k6 * 512;
            if (idx < 46 * 64) { const int r = idx >> 6, c8 = (idx & 63) * 8, row = r0 - 15 + r; u32x4 val = {0u, 0u, 0u, 0u};
                if (row >= seg_lo && row < seg_hi) val = *(const u32x4*)(Glu + (size_t)row * 512 + c8);
                *(u32x4*)(vt + r * 512 + c8) = val; } }
        __syncthreads();
        float v[46];
#pragma unroll
        for (int i = 0; i < 46; ++i) v[i] = bf2f(vt[i * 512 + c]);
#pragma unroll
        for (int t = 0; t < 16; ++t) { float hh = bias;
#pragma unroll
            for (int k = 0; k < 31; ++k) hh += wk[k] * v[t + k];
            hbuf[t * 512 + c] = hh; }
        __syncthreads();
#pragma unroll
        for (int tt = 0; tt < 2; ++tt) { const int t = 2 * w + tt, c8 = lane * 8;
            const f32x4 a = *(const f32x4*)(hbuf + t * 512 + c8), b = *(const f32x4*)(hbuf + t * 512 + c8 + 4);
            const float mean = wave_sum((a[0] + a[1]) + (a[2] + a[3]) + (b[0] + b[1]) + (b[2] + b[3])) * (1.f / 512.f);
            const f32x4 da = a - mean, db = b - mean;
            const float var = wave_sum((da[0] * da[0] + da[1] * da[1]) + (da[2] * da[2] + da[3] * da[3]) + (db[0] * db[0] + db[1] * db[1]) + (db[2] * db[2] + db[3] * db[3])) * (1.f / 512.f);
            const float rstd = rsqrtf(var + EPS);
            const float* gp = p.d_norm_g + l * 512 + c8; const float* bp = p.d_norm_b + l * 512 + c8;
            const f32x4 g0 = *(const f32x4*)gp, g1 = *(const f32x4*)(gp + 4), b0 = *(const f32x4*)bp, b1 = *(const f32x4*)(bp + 4);
            const f32x4 y0 = da * rstd * g0 + b0, y1 = db * rstd * g1 + b1;
            bf16_t* zp = Zd + (size_t)(r0 + t) * 512 + c8; const u32x4 zw = *(const u32x4*)zp;
            u32x4 ow;
            ow.x = pk2(silu(y0[0]) * silu(bf2f(zw.x & 0xffffu)), silu(y0[1]) * silu(bf2f(zw.x >> 16)));
            ow.y = pk2(silu(y0[2]) * silu(bf2f(zw.y & 0xffffu)), silu(y0[3]) * silu(bf2f(zw.y >> 16)));
            ow.z = pk2(silu(y1[0]) * silu(bf2f(zw.z & 0xffffu)), silu(y1[1]) * silu(bf2f(zw.z >> 16)));
            ow.w = pk2(silu(y1[2]) * silu(bf2f(zw.w & 0xffffu)), silu(y1[3]) * silu(bf2f(zw.w >> 16)));
            if (!dry) *(u32x4*)zp = ow; }
        __syncthreads();
    }
}
#define GLA_PT 72
__device__ __forceinline__ int gla_cidx(int c, int dir) { return dir == 0 ? c : (c < 4 ? 3 - c : 39 - c); }
__device__ __forceinline__ void gla_gates(const float* rl, int pitch, const float (&w2c)[16], float b2, int dir, int w, int d, float* segtot, float (&cum)[8], float& tot) {
    float gl[8];
#pragma unroll
    for (int e = 0; e < 8; ++e) { const float* rp = rl + (w * 8 + e) * pitch; float z = b2;
#pragma unroll
        for (int m4 = 0; m4 < 4; ++m4) { const f32x4 rv = *(const f32x4*)(rp + m4 * 4); z += rv[0] * w2c[m4 * 4] + rv[1] * w2c[m4 * 4 + 1] + rv[2] * w2c[m4 * 4 + 2] + rv[3] * w2c[m4 * 4 + 3]; }
        gl[e] = (fminf(z, 0.f) - __logf(1.f + __expf(-fabsf(z)))) * (1.f / 16.f); }
    float run = 0.f;
    if (dir == 0) {
#pragma unroll
        for (int e = 0; e < 8; ++e) { run += gl[e]; cum[e] = run; }
    } else {
#pragma unroll
        for (int e = 7; e >= 0; --e) { run += gl[e]; cum[e] = run; }
    }
    segtot[w * 64 + d] = run;
    __syncthreads();
    float off = 0.f; tot = 0.f;
#pragma unroll
    for (int s2 = 0; s2 < 8; ++s2) { const float sv = segtot[s2 * 64 + d]; tot += sv; if (dir == 0 ? (s2 < w) : (s2 > w)) off += sv; }
#pragma unroll
    for (int e = 0; e < 8; ++e) cum[e] += off;
}
__device__ __forceinline__ float* gla_U(const Params& p) { return (float*)(p.ws + WS_P + (size_t)p.tg * NCOL * 2); }
__device__ __forceinline__ float* gla_Dk(const Params& p) { return (float*)(p.ws + WS_P + (size_t)p.tg * NCOL * 2 + (size_t)p.tg * 4096); }
__device__ __forceinline__ void gla_g1(const Params& p, int l, int g, int item, unsigned char* lds) {
    const int tid = otid(), lane = tid & 63, w = tid >> 6, fr = lane & 15, fq = lane >> 4, tg = p.tg, d = lane;
    const int c = item % 36, x = item / 36, dir = x & 1, h = (x >> 1) & 3, bl = x >> 3;
    const bf16_t* Ck = subbuf(p, C_CK); const bf16_t* Cv = subbuf(p, C_CV);
    const float* R = (const float*)(p.ws + WS_R) + (size_t)g * tg * 32;
    bf16_t* Kht = (bf16_t*)lds; bf16_t* Vt = Kht + 64 * GLA_PT; float* rl = (float*)(Vt + 128 * GLA_PT); float* segtot = rl + 1024;
    bf16_t* ks = (bf16_t*)(segtot + 512); float* wl = (float*)(ks + 64 * GLA_PT);
    const int base = bl * TPB + c * 64;
    *(u32x4*)(ks + (tid >> 3) * GLA_PT + (tid & 7) * 8) = *(const u32x4*)(Ck + (size_t)(base + (tid >> 3)) * 256 + h * 64 + (tid & 7) * 8);
    if (tid < 256) *(f32x4*)(wl + (tid >> 4) * 64 + (tid & 15) * 4) = *(const f32x4*)(p.c_gate_w2 + (((size_t)l * 2 + dir) * 16 + (tid >> 4)) * 256 + h * 64 + (tid & 15) * 4);
    const float b2 = p.c_gate_b[((size_t)l * 2 + dir) * 256 + h * 64 + d];
    u32x4 vc[2];
#pragma unroll
    for (int u2 = 0; u2 < 2; ++u2) { const int idx = tid + 512 * u2; vc[u2] = *(const u32x4*)(Cv + (size_t)(base + (idx >> 4)) * 512 + h * 128 + (idx & 15) * 8); }
    if (tid < 256) *(f32x4*)(rl + (tid >> 2) * 16 + (tid & 3) * 4) = *(const f32x4*)(R + (size_t)(base + (tid >> 2)) * 32 + dir * 16 + (tid & 3) * 4);
#pragma unroll
    for (int u2 = 0; u2 < 2; ++u2) { const int idx = tid + 512 * u2, j = idx >> 4, vg = idx & 15;
#pragma unroll
        for (int e = 0; e < 4; ++e) { Vt[(vg * 8 + 2 * e) * GLA_PT + j] = (bf16_t)(vc[u2][e] & 0xffffu); Vt[(vg * 8 + 2 * e + 1) * GLA_PT + j] = (bf16_t)(vc[u2][e] >> 16); } }
    __syncthreads();
    float w2c[16], kc[8];
#pragma unroll
    for (int m = 0; m < 16; ++m) w2c[m] = wl[m * 64 + d];
#pragma unroll
    for (int e = 0; e < 8; ++e) kc[e] = bf2f(ks[(w * 8 + e) * GLA_PT + d]);
    float cum[8], tot;
    gla_gates(rl, 16, w2c, b2, dir, w, d, segtot, cum, tot);
    { unsigned kh[8];
#pragma unroll
      for (int e = 0; e < 8; ++e) kh[e] = f2bf(kc[e] * __expf(tot - cum[e]));
      u32x4 kw; kw.x = kh[0] | (kh[1] << 16); kw.y = kh[2] | (kh[3] << 16); kw.z = kh[4] | (kh[5] << 16); kw.w = kh[6] | (kh[7] << 16);
      *(u32x4*)(Kht + d * GLA_PT + w * 8) = kw; }
    __syncthreads();
    const int uidx = x * 36 + gla_cidx(c, dir);
    float* Up = gla_U(p) + (size_t)uidx * 8192;
    bf16x8 aV[2];
#pragma unroll
    for (int ks = 0; ks < 2; ++ks) aV[ks] = *(const bf16x8*)(Vt + (w * 16 + fr) * GLA_PT + ks * 32 + fq * 8);
#pragma unroll
    for (int dt = 0; dt < 4; ++dt) { f32x4 acc = {0.f, 0.f, 0.f, 0.f};
#pragma unroll
        for (int ks = 0; ks < 2; ++ks) { const bf16x8 bK = *(const bf16x8*)(Kht + (dt * 16 + fr) * GLA_PT + ks * 32 + fq * 8); acc = __builtin_amdgcn_mfma_f32_16x16x32_bf16(aV[ks], bK, acc, 0, 0, 0); }
#pragma unroll
        for (int jj = 0; jj < 4; ++jj) Up[(w * 16 + fq * 4 + jj) * 64 + dt * 16 + fr] = acc[jj]; }
    if (w == 0) gla_Dk(p)[(size_t)uidx * 64 + d] = __expf(tot);
}
__device__ __forceinline__ void gla_g2(const Params& p, bool dry = false) {
    const int nchain = (p.tg / TPB) * 8, tid = otid();
    float* U = gla_U(p); const float* Dk = gla_Dk(p);
    for (int idx = blockIdx.x * 512 + tid; idx < nchain * 2048; idx += gridDim.x * 512) {
        const int x = idx >> 11, e4 = idx & 2047;
        float* up = U + (size_t)x * 36 * 8192 + e4 * 4; const float* dk = Dk + (size_t)x * 36 * 64 + (e4 & 15) * 4;
        f32x4 S = {0.f, 0.f, 0.f, 0.f};
#pragma unroll 1
        for (int cb = 0; cb < 36; cb += 12) {
            f32x4 t[12], dc[12];
#pragma unroll
            for (int i = 0; i < 12; ++i) { t[i] = *(const f32x4*)(up + (size_t)(cb + i) * 8192); dc[i] = *(const f32x4*)(dk + (cb + i) * 64); }
#pragma unroll
            for (int i = 0; i < 12; ++i) { if (!dry) *(f32x4*)(up + (size_t)(cb + i) * 8192) = S; S = dc[i] * S + t[i]; }
            if (dry && S[0] == 12345.678f) *(f32x4*)up = S;
        }
    }
}
__device__ __forceinline__ void gla_g3(const Params& p, int l, int g, int bl, int h, int c, unsigned char* lds, bool dry = false) {
    const int tid = otid(), lane = tid & 63, w = tid >> 6, fr = lane & 15, fq = lane >> 4, tg = p.tg, d = lane;
    const bf16_t* Cq = subbuf(p, C_CQ); const bf16_t* Ck = subbuf(p, C_CK); const bf16_t* Cv = subbuf(p, C_CV); bf16_t* Zc = subbuf(p, C_ZC);
    const float* R = (const float*)(p.ws + WS_R) + (size_t)g * tg * 32;
    bf16_t* Qt = (bf16_t*)lds; bf16_t* Kt = Qt + 64 * GLA_PT; bf16_t* As = Kt + 64 * GLA_PT; bf16_t* Vt = As + 64 * GLA_PT;
    float* rl = (float*)(Vt + 128 * GLA_PT); float* segtot = rl + 2048; float* part = segtot + 512;
    bf16_t* qs = (bf16_t*)(part + 512); bf16_t* ks = qs + 64 * GLA_PT; float* wl = (float*)(ks + 64 * GLA_PT); float* ot = wl + 2048;
    const int base = bl * TPB + c * 64;
    { const size_t o = (size_t)(base + (tid >> 3)) * 256 + h * 64 + (tid & 7) * 8;
      *(u32x4*)(qs + (tid >> 3) * GLA_PT + (tid & 7) * 8) = *(const u32x4*)(Cq + o); *(u32x4*)(ks + (tid >> 3) * GLA_PT + (tid & 7) * 8) = *(const u32x4*)(Ck + o);
      *(f32x4*)(wl + tid * 4) = *(const f32x4*)(p.c_gate_w2 + (((size_t)l * 2 + (tid >> 8)) * 16 + ((tid >> 4) & 15)) * 256 + h * 64 + (tid & 15) * 4); }
    u32x4 vc[2];
#pragma unroll
    for (int u2 = 0; u2 < 2; ++u2) { const int idx = tid + 512 * u2; vc[u2] = *(const u32x4*)(Cv + (size_t)(base + (idx >> 4)) * 512 + h * 128 + (idx & 15) * 8); }
    *(f32x4*)(rl + (tid >> 3) * 32 + (tid & 7) * 4) = *(const f32x4*)(R + (size_t)(base + (tid >> 3)) * 32 + (tid & 7) * 4);
#pragma unroll
    for (int u2 = 0; u2 < 2; ++u2) { const int idx = tid + 512 * u2, j = idx >> 4, vg = idx & 15;
#pragma unroll
        for (int e = 0; e < 4; ++e) { Vt[(vg * 8 + 2 * e) * GLA_PT + j] = (bf16_t)(vc[u2][e] & 0xffffu); Vt[(vg * 8 + 2 * e + 1) * GLA_PT + j] = (bf16_t)(vc[u2][e] >> 16); } }
    bf16x8 bSall[2][2];
#pragma unroll
    for (int dir = 0; dir < 2; ++dir) { const float* Sp = gla_U(p) + (size_t)(((bl * 4 + h) * 2 + dir) * 36 + gla_cidx(c, dir)) * 8192 + (w * 16 + fr) * 64 + fq * 8;
#pragma unroll
        for (int ks = 0; ks < 2; ++ks) { const f32x4 s0 = *(const f32x4*)(Sp + ks * 32), s1 = *(const f32x4*)(Sp + ks * 32 + 4);
            u32x4 sw; sw.x = pk2(s0[0], s0[1]); sw.y = pk2(s0[2], s0[3]); sw.z = pk2(s1[0], s1[1]); sw.w = pk2(s1[2], s1[3]); bSall[dir][ks] = __builtin_bit_cast(bf16x8, sw); } }
    f32x4 acc[4];
#pragma unroll
    for (int m = 0; m < 4; ++m) acc[m] = (f32x4){0.f, 0.f, 0.f, 0.f};
    __syncthreads();
    float qc[8], kc[8];
#pragma unroll
    for (int e = 0; e < 8; ++e) { qc[e] = bf2f(qs[(w * 8 + e) * GLA_PT + d]) * 0.125f; kc[e] = bf2f(ks[(w * 8 + e) * GLA_PT + d]); }
#pragma unroll
    for (int dir = 0; dir < 2; ++dir) {
        float w2c[16];
#pragma unroll
        for (int m = 0; m < 16; ++m) w2c[m] = wl[(dir * 16 + m) * 64 + d];
        const float b2 = p.c_gate_b[((size_t)l * 2 + dir) * 256 + h * 64 + d];
        const bf16x8 bS[2] = {bSall[dir][0], bSall[dir][1]};
        __syncthreads();
        float cum[8], tot;
        gla_gates(rl + dir * 16, 32, w2c, b2, dir, w, d, segtot, cum, tot);
#pragma unroll
        for (int e = 0; e < 8; ++e) { const int i = w * 8 + e; Qt[i * GLA_PT + d] = (bf16_t)f2bf(qc[e] * __expf(cum[e])); Kt[i * GLA_PT + d] = (bf16_t)f2bf(kc[e] * __expf(-cum[e])); }
        __syncthreads();
        { const int m = w >> 1;
#pragma unroll
          for (int nn = 0; nn < 2; ++nn) { const int n = (w & 1) * 2 + nn; f32x4 sc = {0.f, 0.f, 0.f, 0.f};
#pragma unroll
              for (int ks = 0; ks < 2; ++ks) { const bf16x8 a = *(const bf16x8*)(Qt + (m * 16 + fr) * GLA_PT + ks * 32 + fq * 8), b = *(const bf16x8*)(Kt + (n * 16 + fr) * GLA_PT + ks * 32 + fq * 8);
                  sc = __builtin_amdgcn_mfma_f32_16x16x32_bf16(a, b, sc, 0, 0, 0); }
#pragma unroll
              for (int jj = 0; jj < 4; ++jj) { const int i = m * 16 + fq * 4 + jj, j = n * 16 + fr; const bool keep = dir == 0 ? (j <= i) : (j >= i);
                  As[i * GLA_PT + j] = keep ? (bf16_t)f2bf(sc[jj]) : (bf16_t)0; } } }
        __syncthreads();
        bf16x8 bV[2];
#pragma unroll
        for (int ks = 0; ks < 2; ++ks) bV[ks] = *(const bf16x8*)(Vt + (w * 16 + fr) * GLA_PT + ks * 32 + fq * 8);
#pragma unroll
        for (int m = 0; m < 4; ++m) {
#pragma unroll
            for (int ks = 0; ks < 2; ++ks) { const bf16x8 aA = *(const bf16x8*)(As + (m * 16 + fr) * GLA_PT + ks * 32 + fq * 8), aQ = *(const bf16x8*)(Qt + (m * 16 + fr) * GLA_PT + ks * 32 + fq * 8);
                acc[m] = __builtin_amdgcn_mfma_f32_16x16x32_bf16(aA, bV[ks], acc[m], 0, 0, 0); acc[m] = __builtin_amdgcn_mfma_f32_16x16x32_bf16(aQ, bS[ks], acc[m], 0, 0, 0); } }
    }
#pragma unroll
    for (int m = 0; m < 4; ++m)
#pragma unroll
        for (int jj = 0; jj < 4; ++jj) { float sq = acc[m][jj] * acc[m][jj]; sq += __shfl_xor(sq, 1); sq += __shfl_xor(sq, 2); sq += __shfl_xor(sq, 4); sq += __shfl_xor(sq, 8);
            if (fr == 0) part[w * 64 + m * 16 + fq * 4 + jj] = sq; }
    __syncthreads();
    const float cn = p.c_norm[l * 512 + h * 128 + w * 16 + fr];
#pragma unroll
    for (int m = 0; m < 4; ++m)
#pragma unroll
        for (int jj = 0; jj < 4; ++jj) { const int row = m * 16 + fq * 4 + jj; float ss = 0.f;
#pragma unroll
            for (int w2 = 0; w2 < 8; ++w2) ss += part[w2 * 64 + row];
            ot[row * 132 + w * 16 + fr] = acc[m][jj] * rsqrtf(ss * (1.f / 128.f) + EPS) * cn; }
    __syncthreads();
#pragma unroll
    for (int u2 = 0; u2 < 2; ++u2) { const int idx = tid + 512 * u2, row = idx >> 4, c8 = (idx & 15) * 8;
        bf16_t* zp = Zc + (size_t)(base + row) * 512 + h * 128 + c8; const u32x4 zw = *(const u32x4*)zp;
        const f32x4 o0 = *(const f32x4*)(ot + row * 132 + c8), o1 = *(const f32x4*)(ot + row * 132 + c8 + 4);
        u32x4 ow;
        ow.x = pk2(o0[0] * silu(bf2f(zw.x & 0xffffu)), o0[1] * silu(bf2f(zw.x >> 16))); ow.y = pk2(o0[2] * silu(bf2f(zw.y & 0xffffu)), o0[3] * silu(bf2f(zw.y >> 16)));
        ow.z = pk2(o1[0] * silu(bf2f(zw.z & 0xffffu)), o1[1] * silu(bf2f(zw.z >> 16))); ow.w = pk2(o1[2] * silu(bf2f(zw.w & 0xffffu)), o1[3] * silu(bf2f(zw.w >> 16)));
        if (!dry) *(u32x4*)zp = ow; }
}
#define LAS __attribute__((address_space(3)))
#define XB_TMO      128
#define XB_XCNT(j)  (256  + 64 * (j))
#define XB_XSUB(j)  (1280 + 64 * (j))
#define XB_XGEN(j)  (2304 + 64 * (j))
#define XB_TOP      3328
#define XB_TOPGEN   3392
#define XCD_BAR_WORDS 3456
#define XB_SPIN_CAP (1u << 18)

__device__ __forceinline__ unsigned xb_ld(unsigned* p)              { return __hip_atomic_load(p, __ATOMIC_RELAXED, __HIP_MEMORY_SCOPE_AGENT); }
__device__ __forceinline__ unsigned xb_add(unsigned* p, unsigned v) { return __hip_atomic_fetch_add(p, v, __ATOMIC_RELAXED, __HIP_MEMORY_SCOPE_AGENT); }
__device__ __forceinline__ unsigned xb_xcc_id() { return (unsigned)__builtin_amdgcn_s_getreg((3 << 11) | 20) & 0xFu; }
#define XB_SPIN(cond, bar) do { unsigned _sp = 0; while (cond) { __builtin_amdgcn_s_sleep(1); \
    if ((++_sp & 255u) == 0u) { if (xb_ld(&(bar)[XB_TMO])) break; if (_sp > XB_SPIN_CAP) { atomicAdd(&(bar)[XB_TMO], 1u); break; } } } } while (0)

struct XcdBarrier {
    unsigned* bar; unsigned x;
    volatile LAS unsigned* st;
};

__device__ __forceinline__ XcdBarrier xcd_barrier_post(unsigned* bar, volatile LAS unsigned* st) {
    XcdBarrier b; b.bar = bar; b.x = xb_xcc_id(); b.st = st;
    if (threadIdx.x == 0) (void)xb_add(&bar[XB_XCNT(b.x)], 1u);
    return b;
}
__device__ __forceinline__ void xcd_barrier_complete(unsigned* bar, unsigned x, unsigned& nloc, unsigned& nx) {
    const unsigned G = gridDim.x * gridDim.y * gridDim.z;
    unsigned sum, cnt, mine, sp = 0u;
    for (;;) {
        sum = 0u; cnt = 0u; mine = 0u;
#pragma unroll
        for (unsigned j = 0; j < 16; ++j) { const unsigned c = xb_ld(&bar[XB_XCNT(j)]); sum += c; cnt += (c > 0u) ? 1u : 0u; mine = (j == x) ? c : mine; }
        if (sum == G) break;
        __builtin_amdgcn_s_sleep(1);
        if ((++sp & 255u) == 0u) { if (xb_ld(&bar[XB_TMO])) break; if (sp > XB_SPIN_CAP) { atomicAdd(&bar[XB_TMO], 1u); break; } }
    }
    nloc = mine > 0u ? mine : 1u; nx = cnt > 0u ? cnt : 1u;
}

__device__ __forceinline__ void xcd_barrier(const XcdBarrier& b) {
    asm volatile("s_waitcnt vmcnt(0)" ::: "memory");
    __syncthreads();
    if (threadIdx.x == 0) {
        unsigned* bar = b.bar;
        __builtin_amdgcn_s_waitcnt(0);
        unsigned nloc = b.st[0], nx = b.st[1];
        if (nloc == 0u) { xcd_barrier_complete(bar, b.x, nloc, nx); b.st[0] = nloc; b.st[1] = nx; }
        const unsigned old = xb_add(&bar[XB_XSUB(b.x)], 1u);
        const unsigned gen = old / nloc;
        if (old + 1u == (gen + 1u) * nloc) {
            __builtin_amdgcn_fence(__ATOMIC_RELEASE, "agent");
            asm volatile("s_waitcnt vmcnt(0)" ::: "memory");
            const unsigned og = xb_add(&bar[XB_TOP], 1u);
            const unsigned tg = og / nx;
            if (og + 1u == (tg + 1u) * nx) xb_add(&bar[XB_TOPGEN], 1u);
            else XB_SPIN(xb_ld(&bar[XB_TOPGEN]) == tg, bar);
            __builtin_amdgcn_fence(__ATOMIC_ACQUIRE, "agent");
            xb_add(&bar[XB_XGEN(b.x)], 1u);
            asm volatile("s_waitcnt vmcnt(0)" ::: "memory");
        } else {
            XB_SPIN(xb_ld(&bar[XB_XGEN(b.x)]) == gen, bar);
            __builtin_amdgcn_fence(__ATOMIC_ACQUIRE, "agent");
            asm volatile("s_waitcnt vmcnt(0)" ::: "memory");
        }
    }
    __syncthreads();
}
__device__ __forceinline__ void sum_branches(const Params& p, const bf16_t* Gb, bf16_t* merged) {
    const int tid_ = otid(); const size_t n8 = (size_t)p.tg * 128, gs = (size_t)p.tg * 1024;
    for (size_t i = (size_t)blockIdx.x * 512 + tid_; i < n8; i += (size_t)gridDim.x * 512) {
        const u32x4 a = *(const u32x4*)(Gb + i * 8), b = *(const u32x4*)(Gb + gs + i * 8), c = *(const u32x4*)(Gb + 2 * gs + i * 8), d = *(const u32x4*)(Gb + 3 * gs + i * 8);
        u32x4 o;
#pragma unroll
        for (int e = 0; e < 4; ++e) {
            const float lo = (bf2f(a[e] & 0xffffu) + bf2f(b[e] & 0xffffu)) + (bf2f(c[e] & 0xffffu) + bf2f(d[e] & 0xffffu));
            const float hi = (bf2f(a[e] >> 16) + bf2f(b[e] >> 16)) + (bf2f(c[e] >> 16) + bf2f(d[e] >> 16));
            o[e] = pk2(lo, hi); }
        *(u32x4*)(merged + i * 8) = o;
    }
}
__global__ void __launch_bounds__(512, 2) hybrid_block_fwd(Params p) {
    extern __shared__ __attribute__((aligned(16))) unsigned char lds[];
    cg::grid_group grid = cg::this_grid();
    if (p.ng < 0) grid.sync();
    volatile LAS unsigned* xst = (volatile LAS unsigned*)((LAS unsigned char*)lds + 131072);
    if (threadIdx.x < 2) xst[threadIdx.x] = 0u;
    __syncthreads();
    XcdBarrier xbar = xcd_barrier_post((unsigned*)(p.ws + WS_BAR), xst);
    const int tg = p.tg, G = gridDim.x, bid = blockIdx.x, nb = tg / TPB, tpg = tg / 256;
    const bool dryflag = p.ng > 0;
#if PROBING
    unsigned accA = 0, accB = 0; unsigned long long tprev = __builtin_amdgcn_s_memrealtime();
#define STAMP(k) do { const unsigned long long _now = __builtin_amdgcn_s_memrealtime(); if ((k) == PROBE_A) accA += (unsigned)(_now - tprev); if ((k) == PROBE_B) accB += (unsigned)(_now - tprev); tprev = _now; } while (0)
#else
#define STAMP(k) do { } while (0)
#endif
    const int idle0 = tpg * 4;
    const bool defer = G >= idle0 + 64 && p.ng >= 2;
#if PH & 1
    phase0(p, lds, defer);
#endif
    GSYNC(); STAMP(0);
#if PH & 2
    ln_phase(p, 0, 0, 0, 0, NTOK, nullptr);
#endif
    GSYNC(); STAMP(1);
#pragma unroll 1
    for (int l = 0; l < 2; ++l) {
#pragma unroll 1
        for (int g = 0; g < p.ng; ++g) {
            const bool last = (l == 1);
            if (!defer || (l == 0 && g == 0)) r_items(p, l, g, lds);
            {
                pg8::Gemm gm{(const bf16_t*)(p.ws + WS_U) + (size_t)g * tg * 1024, (const bf16_t*)(p.ws + WS_WIN) + (size_t)l * NCOL * 1024, tg, NCOL, 1024};
                pg8::StaticOrder S; S.init(tg, NCOL, G, bid);
                pg8::EpiP E{p.ws + WS_P, tg};
#if PH & 4
                pg8::gemm_phase<pg8::EpiP, pg8::StaticOrder, true, true>((PG8_LAS unsigned char*)lds, gm, S, E);
#endif
#if REP & 16
                GSYNC();
                pg8::gemm_phase<pg8::EpiP, pg8::StaticOrder, true, true>((PG8_LAS unsigned char*)lds, gm, S, E);
#endif
            }
            GSYNC(); STAMP(2);
#if PH & 8
            qk_prep(p, l);
            short_conv(p, l);
            __syncthreads();
#endif
#if PH & 16
            conformer(p, l, lds, false, last);
#endif
            { const int n_g1 = nb * 8 * 36; for (int it = bid; it < n_g1; it += G) { __syncthreads(); gla_g1(p, l, g, it, lds); } }
            GSYNC();
#if REP & 1024
            conformer(p, l, lds, dryflag); GSYNC();
#endif
#if REP & 2048
            { const int n_g1 = nb * 8 * 36; for (int it = bid; it < n_g1; it += G) { __syncthreads(); gla_g1(p, l, g, it, lds); } } GSYNC();
#endif
#if REP & 128
            qk_prep(p, l, dryflag); short_conv(p, l, dryflag); __syncthreads(); conformer(p, l, lds, dryflag);
            { const int n_g1 = nb * 8 * 36; for (int it = bid; it < n_g1; it += G) { __syncthreads(); gla_g1(p, l, g, it, lds); } }
            GSYNC();
#endif
            gla_g2(p);
#if REP & 512
            GSYNC(); gla_g2(p, dryflag);
#endif
            GSYNC(); STAMP(3);
            {
                const int n_att_lat = nb * 32, n_ctx = last ? 0 : nb * 4, nck = last ? 32 : 36, c0 = last ? 4 : 0, n_g3 = nb * 4 * nck;
                const bf16_t* Aq = subbuf(p, C_AQ); const bf16_t* Ak = subbuf(p, C_AK); const bf16_t* Av = subbuf(p, C_AV); bf16_t* Za = subbuf(p, C_ZA);
                const bool split = G >= n_att_lat + 32;
                int it = bid; const int n_all = n_att_lat + n_ctx + n_g3;
                const int stride = split ? (bid < n_att_lat ? n_all : G - n_att_lat) : G;
                for (; it < n_all; it += stride) {
                    __syncthreads();
                    if (it >= n_att_lat + n_ctx) { const int a = it - n_att_lat - n_ctx, ci = a % nck, bh = a / nck; gla_g3(p, l, g, bh >> 2, bh & 3, c0 + ci, lds); continue; }
                    const int a = (it < n_att_lat && (n_att_lat & 7) == 0) ? (it & 7) * (n_att_lat >> 3) + (it >> 3) : it;
                    int bl, h, qrow0, seq;
                    if (a < n_att_lat) { bl = a >> 5; h = (a >> 3) & 3; qrow0 = bl * TPB + CTX + (a & 7) * 256; seq = TPB; }
                    else { const int a2 = a - n_att_lat; bl = a2 >> 2; h = a2 & 3; qrow0 = bl * TPB; seq = CTX; }
                    const size_t kvo = (size_t)(bl * TPB) * 256 + (h >> 1) * 128;
                    att::attn_dense_body((const att::bf16*)(Aq + (size_t)qrow0 * 512 + h * 128), (const att::bf16*)(Ak + kvo), (const att::bf16*)(Av + kvo),
                                         Za + (size_t)qrow0 * 512 + h * 128, seq, (char*)lds);
                }
            }
            GSYNC(); STAMP(4);
            bf16_t* Gbuf = (bf16_t*)(p.ws + WS_P);
            bf16_t* merged = (bf16_t*)(p.ws + WS_U) + (size_t)g * tg * 1024;
            {
                pg8::Gemm gm{subbuf(p, C_ZA), (const bf16_t*)(p.ws + WS_WBR) + (size_t)l * 4 * 1024 * 512, tg, 1024, 512};
                pg8::BrOrder2 S{last ? (tpg / 9) * 8 * 4 : tpg * 4, G, bid, tpg, last};
                pg8::EpiBr2 E{subbuf(p, C_MG), Gbuf, tpg, (size_t)tg * 1024};
                pg8::gemm_phase<pg8::EpiBr2, pg8::BrOrder2, true, true>((PG8_LAS unsigned char*)lds, gm, S, E);
            }
            GSYNC();
            sum_branches(p, Gbuf, merged);
            GSYNC(); STAMP(6);
            float* hpre = gla_U(p);
            {
                pg8::Gemm gm{merged, (const bf16_t*)(p.ws + WS_WOUT) + (size_t)l * 1024 * 1024, tg, 1024, 1024};
                pg8::StaticOrder S; S.init(tg, 1024, G, bid);
                pg8::EpiOut E{p, hpre, l, g};
#if PH & 512
                pg8::gemm_phase<pg8::EpiOut, pg8::StaticOrder, true, true>((PG8_LAS unsigned char*)lds, gm, S, E);
#endif
#if REP & 32
                GSYNC();
                pg8::gemm_phase<pg8::EpiOut, pg8::StaticOrder, true, true>((PG8_LAS unsigned char*)lds, gm, S, E);
#endif
            }
            if (defer) {
                if (l == 0 && g < 2) weight_prep(p, 1, (1 - g) * 1736, (2 - g) * 1736, idle0, lds);
                const int ng_ = p.ng, gn = g + 1 < ng_ ? g + 1 : 0, ln = g + 1 < ng_ ? l : l + 1;
                if (ln < 2) r_items(p, ln, gn, lds, idle0);
            }
            GSYNC(); STAMP(7);
#if PH & 1024
            ln_phase(p, last ? 2 : 1, l, last ? 1 : l + 1, g * tg, tg, hpre);
#endif
        }
    }
#if PROBING
    if (bid == 0) { float* ex = (float*)lds; if (threadIdx.x == 0) { ex[0] = (float)accA * 0.01f; ex[1] = (float)accB * 0.001f; } __syncthreads();
        if (PROBE_A >= 0 && threadIdx.x == 0) p.out[0] = ex[0];
        if (PROBE_B >= 0) for (int i = threadIdx.x; i < 10000; i += 512) p.out[1024 + i] = ex[1]; }
#endif
}

extern "C" void kernel_launch(void* const* d_in, const int* in_sizes, int n_in, void* d_out, int out_size, void* d_ws, size_t ws_size, hipStream_t stream) {
    static int grid_blocks = 0;
    if (grid_blocks == 0) {
        int dev = 0, cus = 0, per_cu = 0;
        hipGetDevice(&dev);
        hipDeviceGetAttribute(&cus, hipDeviceAttributeMultiprocessorCount, dev);
        hipFuncSetAttribute((const void*)hybrid_block_fwd, hipFuncAttributeMaxDynamicSharedMemorySize, LDS_BYTES);
        hipOccupancyMaxActiveBlocksPerMultiprocessor(&per_cu, (const void*)hybrid_block_fwd, 512, LDS_BYTES);
        if (per_cu < 1) { fprintf(stderr, "kernel_launch: occupancy query reports %d blocks per CU\n", per_cu); per_cu = 1; }
        if (per_cu > 1) per_cu = 1;
        grid_blocks = cus * per_cu;
    }
    Params p{};
    const float** f = (const float**)&p;
    for (int i = 0; i < 21; ++i) f[i] = (const float*)d_in[i];
    p.out = (float*)d_out; p.ws = (unsigned char*)d_ws;
    p.ng = (ws_size >= WS_P + (size_t)9216 * (NCOL * 2 + 4096) + (1u << 20)) ? 2 : 4;
    p.tg = NTOK / p.ng;
    hipMemsetAsync((char*)d_ws + WS_BAR, 0, 16384, stream);
    void* args[] = {&p};
    hipError_t e = hipLaunchCooperativeKernel((const void*)hybrid_block_fwd, dim3(grid_blocks), dim3(512), args, LDS_BYTES, stream);
    if (e != hipSuccess) fprintf(stderr, "cooperative launch failed: %s (grid %d)\n", hipGetErrorString(e), grid_blocks);
}
```
